# Optimizing an MI355X kernel written in HIP

```python
import math
import jax
import jax.numpy as jnp
from jax import lax
import numpy as np

D_MODEL = 2048
BATCH = 8
SEQ = 4096
DEPTH = 4

N_MIXERS = 2
N_LAYERS_A = (DEPTH + 1) // 2
N_LAYERS_B = DEPTH // 2
CHUNK = 128
SGU_WIDTH = D_MODEL
SGU_GROUP = 128
SGU_HEADS = SGU_WIDTH // SGU_GROUP
SSM_WIDTH = D_MODEL
SSM_GROUP = 16
SSM_HEADS = SSM_WIDTH // SSM_GROUP
SSM_STATE = 64
DT_MIN = 1e-3
DT_MAX = 1e-1
FFN_HIDDEN = 5632
CONV_WIDTH = 3
EPS = 1e-6

kernel_name = 'hybrid_sgu_s5_convffn'


def rms_norm(x, g):
    xf = x.astype(jnp.float32)
    y = xf * lax.rsqrt(jnp.mean(xf * xf, axis=-1, keepdims=True) + EPS)
    return (y * g.astype(jnp.float32)).astype(x.dtype)


def chunked_sgu_mixer(h, w_in, g_v, w_s, b_s, w_out):
    bsz, seq, _ = h.shape
    z = jax.nn.gelu(h @ w_in)
    u, v = jnp.split(z, 2, axis=-1)
    v = rms_norm(v, g_v).reshape(bsz, seq // CHUNK, CHUNK, SGU_HEADS, SGU_GROUP)
    causal = jnp.tril(jnp.ones((CHUNK, CHUNK), dtype=bool))
    w = jnp.where(causal[None], w_s, jnp.zeros((), w_s.dtype))
    s = jnp.einsum('hts,bcshd->bcthd', w, v) + b_s.T[:, :, None]
    s = s.reshape(bsz, seq, SGU_WIDTH)
    return (u * s) @ w_out


def _cmul(ar, ai, br, bi):
    return ar * br - ai * bi, ar * bi + ai * br


def _scan_combine(earlier, later):
    a1r, a1i, b1r, b1i = earlier
    a2r, a2i, b2r, b2i = later
    ar, ai = _cmul(a2r, a2i, a1r, a1i)
    br, bi = _cmul(a2r, a2i, b1r, b1i)
    return ar, ai, br + b2r, bi + b2i


def s5_mixer(h, w_in, a_re, a_im, log_dt, b_re, b_im, c_re, c_im, d_skip, w_glu):
    f32 = jnp.float32
    bsz, seq, _ = h.shape
    n_chunks = seq // CHUNK
    u = (h @ w_in).astype(f32).reshape(bsz, n_chunks, CHUNK, SSM_HEADS, SSM_GROUP)
    u = u.transpose(1, 0, 2, 3, 4)
    dt = jnp.exp(log_dt.astype(f32))[:, None]
    lr, li = a_re.astype(f32), a_im.astype(f32)
    mag = jnp.exp(dt * lr)
    abar_r, abar_i = mag * jnp.cos(dt * li), mag * jnp.sin(dt * li)
    den = lr * lr + li * li
    qr = ((abar_r - 1.0) * lr + abar_i * li) / den
    qi = (abar_i * lr - (abar_r - 1.0) * li) / den
    bbar_r, bbar_i = _cmul(qr[..., None], qi[..., None], b_re.astype(f32), b_im.astype(f32))
    cr, ci = c_re.astype(f32), c_im.astype(f32)
    dd = d_skip.astype(f32).reshape(SSM_HEADS, SSM_GROUP)
    a_seq_r = jnp.broadcast_to(abar_r, (bsz, CHUNK, SSM_HEADS, SSM_STATE))
    a_seq_i = jnp.broadcast_to(abar_i, (bsz, CHUNK, SSM_HEADS, SSM_STATE))

    def chunk_step(carry, u_c):
        h0r, h0i = carry
        bur = jnp.einsum('gpc,btgc->btgp', bbar_r, u_c)
        bui = jnp.einsum('gpc,btgc->btgp', bbar_i, u_c)
        pr, pim, hr, hi = lax.associative_scan(
            _scan_combine, (a_seq_r, a_seq_i, bur, bui), axis=1)
        sr, si = _cmul(pr, pim, h0r[:, None], h0i[:, None])
        hr = hr + sr
        hi = hi + si
        y = (jnp.einsum('gcp,btgp->btgc', cr, hr)
             - jnp.einsum('gcp,btgp->btgc', ci, hi)
             + dd * u_c)
        return (hr[:, -1], hi[:, -1]), y

    init = (jnp.zeros((bsz, SSM_HEADS, SSM_STATE), f32),
            jnp.zeros((bsz, SSM_HEADS, SSM_STATE), f32))
    _, y = lax.scan(chunk_step, init, u)
    y = y.transpose(1, 0, 2, 3, 4).reshape(bsz, seq, SSM_WIDTH).astype(h.dtype)
    ga, gb = jnp.split(jax.nn.gelu(y) @ w_glu, 2, axis=-1)
    return ga * jax.nn.sigmoid(gb)


def conv_glu_ffn(h, w_up, conv_w, conv_b, w_down):
    seq = h.shape[1]
    z = h @ w_up
    zp = jnp.pad(z, ((0, 0), (CONV_WIDTH - 1, 0), (0, 0)))
    acc = conv_b + conv_w[CONV_WIDTH - 1] * zp[:, CONV_WIDTH - 1:CONV_WIDTH - 1 + seq]
    for k in range(CONV_WIDTH - 1):
        acc = acc + conv_w[k] * zp[:, k:k + seq]
    gate, val = jnp.split(acc, 2, axis=-1)
    return (jax.nn.silu(gate) * val) @ w_down


def setup_inputs(seed: int = 0) -> dict:
    key = jax.random.key(seed)
    ks = jax.random.split(key, 24)
    f32 = jnp.float32
    d = D_MODEL
    na, nb = N_LAYERS_A, N_LAYERS_B

    def nrm(k, shape, scale):
        return jax.random.normal(k, shape, f32) * scale

    def gain(k, shape):
        return 1.0 + 0.01 * jax.random.normal(k, shape, f32)

    n_idx = jnp.arange(SSM_STATE, dtype=f32)
    return {
        'x': nrm(ks[0], (BATCH, SEQ, d), 1.0),
        'norm_mix_g': gain(ks[1], (DEPTH, d)),
        'norm_ffn_g': gain(ks[2], (DEPTH, d)),
        'a_w_in': nrm(ks[3], (na, d, 2 * SGU_WIDTH), d ** -0.5),
        'a_g_v': gain(ks[4], (na, SGU_WIDTH)),
        'a_w_s': nrm(ks[5], (na, SGU_HEADS, CHUNK, CHUNK), 0.5 * CHUNK ** -0.5),
        'a_b_s': gain(ks[6], (na, SGU_HEADS, CHUNK)),
        'a_w_out': nrm(ks[7], (na, SGU_WIDTH, d), SGU_WIDTH ** -0.5),
        'b_w_in': nrm(ks[8], (nb, d, SSM_WIDTH), d ** -0.5),
        'b_a_re': -0.5 + nrm(ks[9], (nb, SSM_HEADS, SSM_STATE), 0.01),
        'b_a_im': math.pi * n_idx + nrm(ks[10], (nb, SSM_HEADS, SSM_STATE), 0.01),
        'b_log_dt': jax.random.uniform(ks[11], (nb, SSM_HEADS), f32,
                                       minval=math.log(DT_MIN), maxval=math.log(DT_MAX)),
        'b_b_re': nrm(ks[12], (nb, SSM_HEADS, SSM_STATE, SSM_GROUP), (2 * SSM_GROUP) ** -0.5),
        'b_b_im': nrm(ks[13], (nb, SSM_HEADS, SSM_STATE, SSM_GROUP), (2 * SSM_GROUP) ** -0.5),
        'b_c_re': nrm(ks[14], (nb, SSM_HEADS, SSM_GROUP, SSM_STATE), (2 * SSM_STATE) ** -0.5),
        'b_c_im': nrm(ks[15], (nb, SSM_HEADS, SSM_GROUP, SSM_STATE), (2 * SSM_STATE) ** -0.5),
        'b_d': nrm(ks[16], (nb, SSM_WIDTH), 1.0),
        'b_w_glu': nrm(ks[17], (nb, SSM_WIDTH, 2 * d), SSM_WIDTH ** -0.5),
        'f_w_up': nrm(ks[18], (DEPTH, d, 2 * FFN_HIDDEN), d ** -0.5),
        'f_conv_w': nrm(ks[19], (DEPTH, CONV_WIDTH, 2 * FFN_HIDDEN), CONV_WIDTH ** -0.5),
        'f_conv_b': nrm(ks[20], (DEPTH, 2 * FFN_HIDDEN), 0.01),
        'f_w_down': nrm(ks[21], (DEPTH, FFN_HIDDEN, d), FFN_HIDDEN ** -0.5),
        'final_g': gain(ks[22], (d,)),
    }


def reference(x, norm_mix_g, norm_ffn_g, a_w_in, a_g_v, a_w_s, a_b_s, a_w_out,
              b_w_in, b_a_re, b_a_im, b_log_dt, b_b_re, b_b_im, b_c_re, b_c_im, b_d, b_w_glu,
              f_w_up, f_conv_w, f_conv_b, f_w_down, final_g):
    h = x
    for i in range(DEPTH):
        j = i // N_MIXERS
        hn = rms_norm(h, norm_mix_g[i])
        if i % N_MIXERS == 0:
            h = h + chunked_sgu_mixer(hn, a_w_in[j], a_g_v[j], a_w_s[j], a_b_s[j], a_w_out[j])
        else:
            h = h + s5_mixer(hn, b_w_in[j], b_a_re[j], b_a_im[j], b_log_dt[j],
                             b_b_re[j], b_b_im[j], b_c_re[j], b_c_im[j], b_d[j], b_w_glu[j])
        h = h + conv_glu_ffn(rms_norm(h, norm_ffn_g[i]), f_w_up[i], f_conv_w[i],
                             f_conv_b[i], f_w_down[i])
    return rms_norm(h, final_g)
```

```cpp
#include <hip/hip_runtime.h>
#include <hip/hip_cooperative_groups.h>
#include <cstdio>
#include <cstdint>
namespace cg = cooperative_groups;

#ifndef MK_MULTI
#define MK_MULTI 0
#endif

constexpr int M_TOK = 32768, DM = 2048, SEQ = 4096, NBATCH = 8, CHK = 128, FF = 5632, FF2 = 11264, DEPTH = 4;
constexpr float EPS = 1e-6f;
constexpr int NWAVES = 8;
constexpr int LDS_BYTES = 147456;
constexpr int HALO_OFF = 131072, MISC_OFF = 139264, RS_OFF = 139520;

constexpr size_t MiB = 1u << 20;
constexpr size_t WS_ABAR = 1 * MiB;
constexpr size_t WS_BB   = 2 * MiB;
constexpr size_t WS_CM   = 3 * MiB;
constexpr size_t WS_VSS  = 5 * MiB;
constexpr size_t WS_ZH   = 912 * MiB;
constexpr size_t WS_HSS  = 904 * MiB;
constexpr size_t WS_WSB  = 31 * MiB;
constexpr size_t WS_W    = 32 * MiB;
constexpr size_t W_AIN = 0, W_AOUT = 32 * MiB, W_BIN = 48 * MiB, W_GLU = 64 * MiB, W_UP = 96 * MiB, W_DOWN = 272 * MiB;
constexpr size_t S_AIN = 16 * MiB, S_AOUT = 8 * MiB, S_BIN = 8 * MiB, S_GLU = 16 * MiB, S_UP = 44 * MiB, S_DOWN = 22 * MiB;
constexpr size_t WS_XN   = 392 * MiB;
constexpr size_t WS_Z1   = 520 * MiB;
constexpr size_t WS_G    = 776 * MiB;
constexpr size_t WS_HID  = 520 * MiB;
constexpr size_t WS_H2   = 912 * MiB;
constexpr size_t WS_END  = 960 * MiB;
static_assert(W_DOWN + 4 * S_DOWN == 360 * MiB && WS_W + 360 * MiB == WS_XN, "weights map");
static_assert(WS_HID + (size_t)M_TOK * FF * 2 <= WS_HSS, "hid map");

#define LAS __attribute__((address_space(3)))
typedef unsigned short bf16_t;
typedef short bf16x8 __attribute__((ext_vector_type(8)));
typedef float f32x4 __attribute__((ext_vector_type(4)));
typedef float f32x2 __attribute__((ext_vector_type(2)));
typedef unsigned u32x4 __attribute__((ext_vector_type(4)));
typedef unsigned u32x2 __attribute__((ext_vector_type(2)));

__device__ __forceinline__ unsigned cvt_pk_bf16(float lo, float hi) { unsigned r; asm volatile("v_cvt_pk_bf16_f32 %0, %1, %2" : "=v"(r) : "v"(lo), "v"(hi)); return r; }
typedef __bf16 bf16x2_t __attribute__((ext_vector_type(2)));
__device__ __forceinline__ unsigned cvt_pk_bf16_c(float lo, float hi) { f32x2 v = {lo, hi}; bf16x2_t b = __builtin_convertvector(v, bf16x2_t); return __builtin_bit_cast(unsigned, b); }
__device__ __forceinline__ float bf2f(unsigned short b) { return __builtin_bit_cast(float, ((unsigned)b) << 16); }
__device__ __forceinline__ float bflo(unsigned w) { return __builtin_bit_cast(float, w << 16); }
__device__ __forceinline__ float bfhi(unsigned w) { return __builtin_bit_cast(float, w & 0xffff0000u); }
__device__ __forceinline__ float gelu_f(float x) {
    const float t = x * (1.0f + 0.044715f * x * x) * (-1.5957691216057308f * 1.4426950408889634f);
    return x * __builtin_amdgcn_rcpf(1.0f + __builtin_amdgcn_exp2f(t));
}
__device__ __forceinline__ f32x4 gelu4(f32x4 v) { return (f32x4){gelu_f(v[0]), gelu_f(v[1]), gelu_f(v[2]), gelu_f(v[3])}; }
__device__ __forceinline__ float sigmoid_f(float x) { return __builtin_amdgcn_rcpf(1.0f + __builtin_amdgcn_exp2f(-1.4426950408889634f * x)); }
__device__ __forceinline__ float wave_sum(float v) {
#pragma unroll
    for (int o = 1; o < 64; o <<= 1) v += __shfl_xor(v, o);
    return v;
}
__device__ __forceinline__ float dpp_ror1(float x) { return __builtin_bit_cast(float, __builtin_amdgcn_update_dpp(0, __builtin_bit_cast(int, x), 0x121, 0xF, 0xF, false)); }
__device__ __forceinline__ float dpp_ror2(float x) { return __builtin_bit_cast(float, __builtin_amdgcn_update_dpp(0, __builtin_bit_cast(int, x), 0x122, 0xF, 0xF, false)); }
__device__ __forceinline__ float dpp_shr1_old(float old, float x) { return __builtin_bit_cast(float, __builtin_amdgcn_update_dpp(__builtin_bit_cast(int, old), __builtin_bit_cast(int, x), 0x111, 0xF, 0xF, false)); }
__device__ __forceinline__ float dpp_shr2_old(float old, float x) { return __builtin_bit_cast(float, __builtin_amdgcn_update_dpp(__builtin_bit_cast(int, old), __builtin_bit_cast(int, x), 0x112, 0xF, 0xF, false)); }
template <int CTRL> __device__ __forceinline__ float dpp_z(float x) { return __builtin_bit_cast(float, __builtin_amdgcn_update_dpp(0, __builtin_bit_cast(int, x), CTRL, 0xF, 0xF, true)); }
#define LDS_BARRIER() do { asm volatile("s_waitcnt lgkmcnt(0)" ::: "memory"); __builtin_amdgcn_s_barrier(); asm volatile("" ::: "memory"); } while (0)

#define XB_TMO      128
#define XB_XCNT(j)  (256  + 64 * (j))
#define XB_XSUB(j)  (1280 + 64 * (j))
#define XB_XGEN(j)  (2304 + 64 * (j))
#define XB_TOP      3328
#define XB_TOPGEN   3392
#define XCD_BAR_WORDS 3456
#define XB_SPIN_CAP (1u << 18)

__device__ __forceinline__ unsigned xb_ld(unsigned* p)              { return __hip_atomic_load(p, __ATOMIC_RELAXED, __HIP_MEMORY_SCOPE_AGENT); }
__device__ __forceinline__ unsigned xb_add(unsigned* p, unsigned v) { return __hip_atomic_fetch_add(p, v, __ATOMIC_RELAXED, __HIP_MEMORY_SCOPE_AGENT); }
__device__ __forceinline__ unsigned xb_xcc_id() { return (unsigned)__builtin_amdgcn_s_getreg((3 << 11) | 20) & 0xFu; }
#define XB_SPIN(cond, bar) do { unsigned _sp = 0; while (cond) { __builtin_amdgcn_s_sleep(1); \
    if ((++_sp & 255u) == 0u) { if (xb_ld(&(bar)[XB_TMO])) break; if (_sp > XB_SPIN_CAP) { atomicAdd(&(bar)[XB_TMO], 1u); break; } } } } while (0)

struct XcdBarrier {
    unsigned* bar; unsigned x;
    volatile LAS unsigned* st;
};

__device__ __forceinline__ XcdBarrier xcd_barrier_post(unsigned* bar, volatile LAS unsigned* st) {
    XcdBarrier b; b.bar = bar; b.x = xb_xcc_id(); b.st = st;
    if (threadIdx.x == 0) (void)xb_add(&bar[XB_XCNT(b.x)], 1u);
    return b;
}
__device__ __forceinline__ void xcd_barrier_complete(unsigned* bar, unsigned x, unsigned& nloc, unsigned& nx) {
    const unsigned G = gridDim.x * gridDim.y * gridDim.z;
    unsigned sum, cnt, mine, sp = 0u;
    for (;;) {
        sum = 0u; cnt = 0u; mine = 0u;
#pragma unroll
        for (unsigned j = 0; j < 16; ++j) { const unsigned c = xb_ld(&bar[XB_XCNT(j)]); sum += c; cnt += (c > 0u) ? 1u : 0u; mine = (j == x) ? c : mine; }
        if (sum == G) break;
        __builtin_amdgcn_s_sleep(1);
        if ((++sp & 255u) == 0u) { if (xb_ld(&bar[XB_TMO])) break; if (sp > XB_SPIN_CAP) { atomicAdd(&bar[XB_TMO], 1u); break; } }
    }
    nloc = mine > 0u ? mine : 1u; nx = cnt > 0u ? cnt : 1u;
}

__device__ __forceinline__ void xcd_barrier(const XcdBarrier& b) {
    asm volatile("s_waitcnt vmcnt(0)" ::: "memory");
    __syncthreads();
    if (threadIdx.x == 0) {
        unsigned* bar = b.bar;
        __builtin_amdgcn_s_waitcnt(0);
        unsigned nloc = b.st[0], nx = b.st[1];
        if (nloc == 0u) { xcd_barrier_complete(bar, b.x, nloc, nx); b.st[0] = nloc; b.st[1] = nx; }
        const unsigned old = xb_add(&bar[XB_XSUB(b.x)], 1u);
        const unsigned gen = old / nloc;
        if (old + 1u == (gen + 1u) * nloc) {
            __builtin_amdgcn_fence(__ATOMIC_RELEASE, "agent");
            asm volatile("s_waitcnt vmcnt(0)" ::: "memory");
            const unsigned og = xb_add(&bar[XB_TOP], 1u);
            const unsigned tg = og / nx;
            if (og + 1u == (tg + 1u) * nx) xb_add(&bar[XB_TOPGEN], 1u);
            else XB_SPIN(xb_ld(&bar[XB_TOPGEN]) == tg, bar);
            __builtin_amdgcn_fence(__ATOMIC_ACQUIRE, "agent");
            xb_add(&bar[XB_XGEN(b.x)], 1u);
            asm volatile("s_waitcnt vmcnt(0)" ::: "memory");
        } else {
            XB_SPIN(xb_ld(&bar[XB_XGEN(b.x)]) == gen, bar);
            __builtin_amdgcn_fence(__ATOMIC_ACQUIRE, "agent");
            asm volatile("s_waitcnt vmcnt(0)" ::: "memory");
        }
    }
    __syncthreads();
}

namespace pg8 {
#define PG8_LAS __attribute__((address_space(3)))
typedef unsigned short bf16_t;
typedef short bf16x8 __attribute__((ext_vector_type(8)));
typedef float f32x4 __attribute__((ext_vector_type(4)));
typedef unsigned u32x4 __attribute__((ext_vector_type(4)));
constexpr int BM = 256, BK = 64, HALF = 128, HTB = HALF * BK * 2  , STAGE_BYTES = 8 * HTB, NXCD = 8, WGM = 8;

__host__ __device__ __forceinline__ int lds_byte(int r, int c) { const int st = (r >> 4) * 2 + (c >> 5), rr = r & 15, cc = c & 31, ob = rr * 64 + cc * 2; return st * 1024 + (ob ^ (((ob >> 9) & 1) << 5)); }
__host__ __device__ __forceinline__ void stage_rc(int b, int& R, int& C) { const int st = b / 1024, sb = b % 1024, swz = sb ^ (((sb >> 9) & 1) << 5); R = (st >> 1) * 16 + swz / 64; C = (st & 1) * 32 + (swz % 64) / 2; }
__host__ __device__ __forceinline__ int perm32(int rho) { const int n = rho >> 4, i = rho & 15; return 8 * (i >> 2) + 4 * n + (i & 3); }

struct Unit { int pm, pn; };
struct Gemm { const bf16_t* A; const bf16_t* Bt; int M, N, K; };

struct StaticOrder {
    int nM, nN, nwg, G, c, wgm;
    __host__ __device__ void init(int M, int N, int G_, int c_, int wgm_ = WGM) { nM = M / BM; nN = N / BM; nwg = nM * nN; G = G_; c = c_; wgm = wgm_; }
    __host__ __device__ bool next(int i, Unit& u) const {
        const long L = (long)i * G + c; if (L >= nwg) return false;
        int wgid = (int)L; { const int q = nwg / NXCD, r = nwg % NXCD, xcd = wgid % NXCD, off = wgid / NXCD; wgid = (xcd < r ? xcd * (q + 1) : r * (q + 1) + (xcd - r) * q) + off; }
        const int nig = wgm * nN, gid = wgid / nig, fm = gid * wgm, gsz = (nM - fm) < wgm ? (nM - fm) : wgm;
        u.pm = fm + ((wgid % nig) % gsz); u.pn = (wgid % nig) / gsz; return true;
    }
    __device__ __forceinline__ void a_ready(const Unit&) const {}
    __device__ __forceinline__ void done(const Unit&) const {}
};


__device__ __forceinline__ void load_rs(float (&rs)[2][4], PG8_LAS unsigned char* lds, const Unit& u, int pm0, int wr, int fr) {
    const PG8_LAS float* RS = (const PG8_LAS float*)(lds + RS_OFF) + (u.pm != pm0 ? 256 : 0) + wr * 64 + fr;
#pragma unroll
    for (int ai = 0; ai < 2; ++ai)
#pragma unroll
        for (int m = 0; m < 4; ++m) rs[ai][m] = RS[ai * HALF + m * 16];
}
struct EpiGeluSS {
    static constexpr bool PERM = true, AFTER_DRAIN = false, APERM = false;
    bf16_t* O; float* vss; int pm0;
    __device__ __forceinline__ void operator()(f32x4 (&acc)[2][2][4][2], const Unit& u, int wr, int wc, int fr, int fq, PG8_LAS unsigned char* lds) const {
        const int row0 = u.pm * BM + wr * 64 + fr, col0 = u.pn * BM + wc * 32 + 8 * fq;
        const bool isv = u.pn >= 8;
        float rs[2][4]; load_rs(rs, lds, u, pm0, wr, fr);
#pragma unroll
        for (int ai = 0; ai < 2; ++ai)
#pragma unroll
            for (int m = 0; m < 4; ++m) { const int row = row0 + ai * HALF + m * 16; bf16_t* rowp = O + (size_t)row * 4096 + col0; float ss = 0.f;
#pragma unroll
                for (int bj = 0; bj < 2; ++bj) { const f32x4 v0 = gelu4(acc[ai][bj][m][0] * rs[ai][m]), v1 = gelu4(acc[ai][bj][m][1] * rs[ai][m]);
                    ss += (v0[0] * v0[0] + v0[1] * v0[1]) + (v0[2] * v0[2] + v0[3] * v0[3]) + (v1[0] * v1[0] + v1[1] * v1[1]) + (v1[2] * v1[2] + v1[3] * v1[3]);
                    u32x4 w; w.x = cvt_pk_bf16(v0[0], v0[1]); w.y = cvt_pk_bf16(v0[2], v0[3]); w.z = cvt_pk_bf16(v1[0], v1[1]); w.w = cvt_pk_bf16(v1[2], v1[3]);
                    *(u32x4*)(rowp + bj * HALF) = w; }
                if (isv) { ss += __shfl_xor(ss, 16); ss += __shfl_xor(ss, 32); if (fq == 0) vss[(size_t)row * 32 + (u.pn - 8) * 4 + wc] = ss; } }
    }
};
struct EpiPlainBf16 {
    static constexpr bool PERM = true, AFTER_DRAIN = false, APERM = false;
    bf16_t* O; int ldc; int pm0;
    __device__ __forceinline__ void operator()(f32x4 (&acc)[2][2][4][2], const Unit& u, int wr, int wc, int fr, int fq, PG8_LAS unsigned char* lds) const {
        const int row0 = u.pm * BM + wr * 64 + fr, col0 = u.pn * BM + wc * 32 + 8 * fq;
        float rs[2][4]; load_rs(rs, lds, u, pm0, wr, fr);
#pragma unroll
        for (int ai = 0; ai < 2; ++ai)
#pragma unroll
            for (int m = 0; m < 4; ++m) { bf16_t* rowp = O + (size_t)(row0 + ai * HALF + m * 16) * ldc + col0;
#pragma unroll
                for (int bj = 0; bj < 2; ++bj) { const f32x4 v0 = acc[ai][bj][m][0] * rs[ai][m], v1 = acc[ai][bj][m][1] * rs[ai][m];
                    u32x4 w; w.x = cvt_pk_bf16(v0[0], v0[1]); w.y = cvt_pk_bf16(v0[2], v0[3]); w.z = cvt_pk_bf16(v1[0], v1[1]); w.w = cvt_pk_bf16(v1[2], v1[3]);
                    *(u32x4*)(rowp + bj * HALF) = w; } }
    }
};
__device__ __forceinline__ f32x4 bf4lo(u32x4 r) { return (f32x4){bflo(r.x), bfhi(r.x), bflo(r.y), bfhi(r.y)}; }
__device__ __forceinline__ f32x4 bf4hi(u32x4 r) { return (f32x4){bflo(r.z), bfhi(r.z), bflo(r.w), bfhi(r.w)}; }
struct EpiRes {
    static constexpr bool PERM = true, AFTER_DRAIN = false, APERM = false;
    bf16_t* xn; float* hss; int pm0;
    __device__ __forceinline__ void operator()(f32x4 (&acc)[2][2][4][2], const Unit& u, int wr, int wc, int fr, int fq, PG8_LAS unsigned char*) const {
        const int row0 = u.pm * BM + wr * 64 + fr, col0 = u.pn * BM + wc * 32 + 8 * fq;
        u32x4 rb[8][2];
#define RES_LOAD(g) do { const size_t off_ = (size_t)(row0 + ((g) >> 2) * HALF + ((g) & 3) * 16) * DM + col0; rb[g][0] = *(const u32x4*)(xn + off_); rb[g][1] = *(const u32x4*)(xn + off_ + HALF); } while (0)
        RES_LOAD(0); RES_LOAD(1); RES_LOAD(2); RES_LOAD(3);
        asm volatile("" ::: "memory");
#pragma unroll
        for (int g = 0; g < 8; ++g) { const int ai = g >> 2, m = g & 3;
            if (g + 4 < 8) RES_LOAD((g + 4 < 8 ? g + 4 : 7));
            const int row = row0 + ai * HALF + m * 16; const size_t off = (size_t)row * DM + col0; float ss = 0.f;
#pragma unroll
            for (int bj = 0; bj < 2; ++bj) {
                const f32x4 o0 = bf4lo(rb[g][bj]) + acc[ai][bj][m][0], o1 = bf4hi(rb[g][bj]) + acc[ai][bj][m][1];
                ss += (o0[0] * o0[0] + o0[1] * o0[1]) + (o0[2] * o0[2] + o0[3] * o0[3]) + (o1[0] * o1[0] + o1[1] * o1[1]) + (o1[2] * o1[2] + o1[3] * o1[3]);
                u32x4 w; w.x = cvt_pk_bf16(o0[0], o0[1]); w.y = cvt_pk_bf16(o0[2], o0[3]); w.z = cvt_pk_bf16(o1[0], o1[1]); w.w = cvt_pk_bf16(o1[2], o1[3]);
                *(u32x4*)(xn + off + bj * HALF) = w; }
            ss += __shfl_xor(ss, 16); ss += __shfl_xor(ss, 32); if (fq == 0) hss[(size_t)row * 64 + u.pn * 4 + wc] = ss;
            asm volatile("" ::: "memory"); }
#undef RES_LOAD
    }
};
struct EpiGlu {
    static constexpr bool PERM = true, AFTER_DRAIN = false, APERM = false;
    bf16_t* xn; float* hss; int pm0;
    __device__ __forceinline__ void operator()(f32x4 (&acc)[2][2][4][2], const Unit& u, int wr, int wc, int fr, int fq, PG8_LAS unsigned char*) const {
        const int row0 = u.pm * BM + wr * 64 + fr, col0 = u.pn * HALF + wc * 32 + 8 * fq;
        u32x4 rb[8];
#define RES_LOAD(g) do { const size_t off_ = (size_t)(row0 + ((g) >> 2) * HALF + ((g) & 3) * 16) * DM + col0; rb[g] = *(const u32x4*)(xn + off_); } while (0)
        RES_LOAD(0); RES_LOAD(1); RES_LOAD(2); RES_LOAD(3);
        asm volatile("" ::: "memory");
#pragma unroll
        for (int g = 0; g < 8; ++g) { const int ai = g >> 2, m = g & 3;
            if (g + 4 < 8) RES_LOAD((g + 4 < 8 ? g + 4 : 7));
            const int row = row0 + ai * HALF + m * 16; const size_t off = (size_t)row * DM + col0; float ss = 0.f;
            f32x4 o[2]; o[0] = bf4lo(rb[g]); o[1] = bf4hi(rb[g]);
#pragma unroll
            for (int n = 0; n < 2; ++n) { const f32x4 ga = acc[ai][0][m][n], gb = acc[ai][1][m][n];
#pragma unroll
                for (int j = 0; j < 4; ++j) o[n][j] += ga[j] * sigmoid_f(gb[j]);
                ss += (o[n][0] * o[n][0] + o[n][1] * o[n][1]) + (o[n][2] * o[n][2] + o[n][3] * o[n][3]); }
            u32x4 w; w.x = cvt_pk_bf16(o[0][0], o[0][1]); w.y = cvt_pk_bf16(o[0][2], o[0][3]); w.z = cvt_pk_bf16(o[1][0], o[1][1]); w.w = cvt_pk_bf16(o[1][2], o[1][3]);
            *(u32x4*)(xn + off) = w;
            ss += __shfl_xor(ss, 16); ss += __shfl_xor(ss, 32); if (fq == 0) hss[(size_t)row * 64 + u.pn * 4 + wc] = ss;
            asm volatile("" ::: "memory"); }
#undef RES_LOAD
    }
};
struct EpiUp {
    static constexpr bool PERM = true, AFTER_DRAIN = false, APERM = true;
    bf16_t* HID; float* ZH; const float* cw; const float* cb; int pm0;
    __device__ __forceinline__ void operator()(f32x4 (&acc)[2][2][4][2], const Unit& u, int wr, int wc, int fr, int fq, PG8_LAS unsigned char* lds) const {
        const int tcol = wc * 32 + 8 * fq;
        const int tl0 = 8 * (16 * wr + fr);
        { const PG8_LAS float* RS = (const PG8_LAS float*)(lds + RS_OFF) + (u.pm != pm0 ? 256 : 0) + tl0;
          const f32x4 ra = *(const PG8_LAS f32x4*)RS, rb = *(const PG8_LAS f32x4*)(RS + 4);
#pragma unroll
          for (int bj = 0; bj < 2; ++bj)
#pragma unroll
            for (int n = 0; n < 2; ++n) {
#pragma unroll
              for (int m = 0; m < 4; ++m) { acc[0][bj][m][n] = acc[0][bj][m][n] * ra[m]; acc[1][bj][m][n] = acc[1][bj][m][n] * rb[m]; } } }
        if (fr == 0 || fr == 15) {
            const int slot = 4 * wr + (fr == 15 ? 2 : 0);
#pragma unroll
            for (int bj = 0; bj < 2; ++bj)
#pragma unroll
                for (int n = 0; n < 2; ++n) { float* z = ZH + (size_t)(u.pm * 8 + slot) * FF2 + bj * FF + u.pn * HALF + tcol + 4 * n;
                    *(f32x4*)z = (fr == 0) ? acc[0][bj][0][n] : acc[1][bj][2][n]; *(f32x4*)(z + FF2) = (fr == 0) ? acc[0][bj][1][n] : acc[1][bj][3][n]; }
        }
#pragma unroll
        for (int n = 0; n < 2; ++n)
#pragma unroll
            for (int bj = 0; bj < 2; ++bj) {
                const int c = bj * FF + u.pn * HALF + tcol + 4 * n;
                const f32x4 w0 = *(const f32x4*)(cw + c), w1 = *(const f32x4*)(cw + FF2 + c), w2 = *(const f32x4*)(cw + 2 * FF2 + c), bb = *(const f32x4*)(cb + c);
                f32x4 h6 = (f32x4){0.f, 0.f, 0.f, 0.f}, h7 = h6;
                f32x4 s6, s7;
#pragma unroll
                for (int j = 0; j < 4; ++j) { s6[j] = dpp_shr1_old(h6[j], acc[1][bj][2][n][j]); s7[j] = dpp_shr1_old(h7[j], acc[1][bj][3][n][j]); }
#pragma unroll
                for (int r8 = 7; r8 >= 0; --r8) {
                    const f32x4 zc = acc[r8 >> 2][bj][r8 & 3][n];
                    const f32x4 z1 = (r8 >= 1) ? acc[(r8 >= 1 ? r8 - 1 : 0) >> 2][bj][(r8 >= 1 ? r8 - 1 : 0) & 3][n] : s7;
                    const f32x4 z2 = (r8 >= 2) ? acc[(r8 >= 2 ? r8 - 2 : 0) >> 2][bj][(r8 >= 2 ? r8 - 2 : 0) & 3][n] : (r8 == 1 ? s7 : s6);
                    f32x4 r;
#pragma unroll
                    for (int j = 0; j < 4; ++j) r[j] = __builtin_fmaf(w0[j], z2[j], __builtin_fmaf(w1[j], z1[j], __builtin_fmaf(w2[j], zc[j], bb[j])));
                    acc[r8 >> 2][bj][r8 & 3][n] = r;
                    asm volatile("" : "+v"(acc[r8 >> 2][bj][r8 & 3][n]));
                }
                asm volatile("" ::: "memory");
            }
#pragma unroll
        for (int ai = 0; ai < 2; ++ai)
#pragma unroll
            for (int m = 0; m < 4; ++m) {
                bf16_t* rowp = HID + (size_t)(u.pm * BM + tl0 + 4 * ai + m) * FF + u.pn * HALF + tcol;
                float o[8];
#pragma unroll
                for (int n = 0; n < 2; ++n)
#pragma unroll
                    for (int j = 0; j < 4; ++j) { const float g = acc[ai][0][m][n][j], v = acc[ai][1][m][n][j]; o[4 * n + j] = g * sigmoid_f(g) * v; }
                u32x4 w; w.x = cvt_pk_bf16(o[0], o[1]); w.y = cvt_pk_bf16(o[2], o[3]); w.z = cvt_pk_bf16(o[4], o[5]); w.w = cvt_pk_bf16(o[6], o[7]);
                *(u32x4*)rowp = w;
            }
    }
};
template <class Epi, class Sched, bool ALIGN_EPI = false, bool SP2 = false>
__device__ __forceinline__ void gemm_phase(PG8_LAS unsigned char* lds, const Gemm g, const Sched& S, const Epi& E, const int tid_in) {
    const int tid = tid_in, wid = __builtin_amdgcn_readfirstlane(tid >> 6), lane = tid & 63, wr = wid >> 2, wc = wid & 3, fr = lane & 15, fq = lane >> 4;
    const int K = g.K, nt = K / BK;
    unsigned voffA[2], voffB[2];
#pragma unroll
    for (int i = 0; i < 2; ++i) { int R, C; stage_rc(tid * 16 + i * 8192, R, C); const int Rb = Epi::PERM ? ((R & ~31) + perm32(R & 31)) : R;
        const int Ra = Epi::APERM ? (8 * (16 * ((R >> 6) & 1) + (R & 15)) + ((R >> 4) & 3)) : R; voffA[i] = (unsigned)(Ra * K + C) * 2u; voffB[i] = (unsigned)(Rb * K + C) * 2u; }
    const size_t kstep = (size_t)(BK * 2);
    const size_t hstep = (size_t)HALF * K * 2;
    const size_t tstep = 2 * hstep;
    const size_t hstepA = Epi::APERM ? (size_t)4 * K * 2 : hstep;
    const unsigned ldsw = (unsigned)wid * 1024u;
    const int aoff = lds_byte(wr * 64 + fr, fq * 8), boff = lds_byte(wc * 32 + fr, fq * 8);
#define PG8_SA(b, h) (((b) * 2 + (h)) * HTB)
#define PG8_SB(b, h) ((4 + (b) * 2 + (h)) * HTB)
#define PG8_STAGE(bufoff, gbase, voff) do { _Pragma("unroll") for (int _i = 0; _i < 2; ++_i) \
        __builtin_amdgcn_global_load_lds((const unsigned*)((const char*)(gbase) + (voff)[_i]), (PG8_LAS unsigned*)(lds + (bufoff) + ldsw + _i * 8192), 16, 0, 0); } while (0)
#define PG8_LDA(dst, b, h) do { _Pragma("unroll") for (int m = 0; m < 4; ++m) _Pragma("unroll") for (int k = 0; k < 2; ++k) dst[m][k] = *(const PG8_LAS bf16x8*)(lds + PG8_SA(b, h) + aoff + m * 2048 + k * 1024); } while (0)
#define PG8_LDB(dst, b, h) do { _Pragma("unroll") for (int n = 0; n < 2; ++n) _Pragma("unroll") for (int k = 0; k < 2; ++k) dst[n][k] = *(const PG8_LAS bf16x8*)(lds + PG8_SB(b, h) + boff + n * 2048 + k * 1024); } while (0)
#define PG8_MMA(ai, bj, At, Bt) do { __builtin_amdgcn_s_setprio(3); _Pragma("unroll") for (int m = 0; m < 4; ++m) _Pragma("unroll") for (int n = 0; n < 2; ++n) _Pragma("unroll") for (int k = 0; k < 2; ++k) \
        acc[ai][bj][m][n] = __builtin_amdgcn_mfma_f32_16x16x32_bf16(Bt[n][k], At[m][k], acc[ai][bj][m][n], 0, 0, 0); __builtin_amdgcn_s_setprio(0); } while (0)
#define PG8_WAIT_V(n) asm volatile("s_waitcnt vmcnt(" #n ")" ::: "memory")
#define PG8_WAIT_L(n) asm volatile("s_waitcnt lgkmcnt(" #n ")" ::: "memory")
#define PG8_BAR __builtin_amdgcn_s_barrier()
#define PG8_SCHED __builtin_amdgcn_sched_barrier(0)
    Unit cur, nxt; int ui = 0;
    if (!S.next(0, cur)) return;
    f32x4 acc[2][2][4][2];
#pragma unroll
    for (int a = 0; a < 2; ++a)
#pragma unroll
        for (int b = 0; b < 2; ++b)
#pragma unroll
            for (int m = 0; m < 4; ++m)
#pragma unroll
                for (int n = 0; n < 2; ++n) acc[a][b][m][n] = (f32x4){0.f, 0.f, 0.f, 0.f};
    bf16x8 At[4][2], B0[2][2], B1[2][2];
    const char* cA = (const char*)g.A + (size_t)cur.pm * tstep; const char* cB = (const char*)g.Bt + (size_t)cur.pn * tstep;
    S.a_ready(cur);
    if constexpr (SP2) {
        PG8_STAGE(PG8_SB(0, 0), cB, voffB); PG8_STAGE(PG8_SB(0, 1), cB + hstep, voffB); PG8_STAGE(PG8_SA(0, 0), cA, voffA); PG8_STAGE(PG8_SA(0, 1), cA + hstepA, voffA);
        if (wr == 1) PG8_BAR;
        PG8_WAIT_V(2); PG8_BAR;
        PG8_STAGE(PG8_SB(1, 0), cB + kstep, voffB); PG8_STAGE(PG8_SA(1, 0), cA + kstep, voffA); PG8_STAGE(PG8_SB(1, 1), cB + hstep + kstep, voffB);
        PG8_WAIT_V(6); PG8_BAR;
    } else {
        PG8_STAGE(PG8_SB(0, 0), cB, voffB); PG8_STAGE(PG8_SA(0, 0), cA, voffA); PG8_STAGE(PG8_SB(0, 1), cB + hstep, voffB); PG8_STAGE(PG8_SA(0, 1), cA + hstepA, voffA);
        if (wr == 1) PG8_BAR;
        PG8_WAIT_V(4); PG8_BAR;
        PG8_STAGE(PG8_SB(1, 0), cB + kstep, voffB); PG8_STAGE(PG8_SA(1, 0), cA + kstep, voffA); PG8_STAGE(PG8_SB(1, 1), cB + hstep + kstep, voffB);
        PG8_WAIT_V(6); PG8_BAR;
    }
    for (;;) {
        const bool has_next = S.next(ui + 1, nxt);
        const char* nA = has_next ? (const char*)g.A + (size_t)nxt.pm * tstep : cA; const char* nB = has_next ? (const char*)g.Bt + (size_t)nxt.pn * tstep : cB;
        for (int t = 0; t < nt; t += 2) {
            const bool last = (t == nt - 2);
            const char* a1 = cA + (size_t)(t + 1) * kstep;
            const char* a2 = last ? nA : cA + (size_t)(t + 2) * kstep; const char* b2 = last ? nB : cB + (size_t)(t + 2) * kstep;
            const char* a3 = a2 + kstep; const char* b3 = b2 + kstep;
            if (last && has_next) S.a_ready(nxt);
            if constexpr (SP2) {
            PG8_LDB(B0, 0, 0); PG8_LDB(B1, 0, 1); PG8_SCHED; PG8_LDA(At, 0, 0); PG8_STAGE(PG8_SA(1, 1), a1 + hstepA, voffA);
            PG8_WAIT_V(8); PG8_WAIT_L(0); PG8_BAR; PG8_MMA(0, 0, At, B0); PG8_MMA(0, 1, At, B1); PG8_BAR; PG8_SCHED;
            PG8_LDA(At, 0, 1); PG8_STAGE(PG8_SB(0, 0), b2, voffB); PG8_STAGE(PG8_SB(0, 1), b2 + hstep, voffB); PG8_STAGE(PG8_SA(0, 0), a2, voffA);
            PG8_WAIT_V(8); PG8_WAIT_L(0); PG8_BAR; PG8_MMA(1, 0, At, B0); PG8_MMA(1, 1, At, B1); PG8_BAR; PG8_SCHED;
            PG8_LDB(B0, 1, 0); PG8_LDB(B1, 1, 1); PG8_SCHED; PG8_LDA(At, 1, 0); PG8_STAGE(PG8_SA(0, 1), a2 + hstepA, voffA);
            PG8_WAIT_V(8); PG8_WAIT_L(0); PG8_BAR; PG8_MMA(0, 0, At, B0); PG8_MMA(0, 1, At, B1); PG8_BAR; PG8_SCHED;
            PG8_LDA(At, 1, 1); PG8_STAGE(PG8_SB(1, 0), b3, voffB); PG8_STAGE(PG8_SB(1, 1), b3 + hstep, voffB); PG8_STAGE(PG8_SA(1, 0), a3, voffA);
            PG8_WAIT_V(8); PG8_WAIT_L(0); PG8_BAR; PG8_MMA(1, 0, At, B0); PG8_MMA(1, 1, At, B1); PG8_BAR; PG8_SCHED;
            } else {
            PG8_LDB(B0, 0, 0); PG8_SCHED; PG8_LDA(At, 0, 0); PG8_STAGE(PG8_SA(1, 1), a1 + hstepA, voffA);
            PG8_WAIT_L(8); PG8_BAR; PG8_WAIT_L(0); PG8_MMA(0, 0, At, B0); PG8_BAR; PG8_SCHED;
            PG8_LDB(B1, 0, 1); PG8_STAGE(PG8_SB(0, 0), b2, voffB);
            PG8_BAR; PG8_WAIT_L(0); PG8_MMA(0, 1, At, B1); PG8_BAR;
            PG8_LDA(At, 0, 1); PG8_STAGE(PG8_SA(0, 0), a2, voffA);
            PG8_BAR; PG8_WAIT_L(0); PG8_MMA(1, 0, At, B0); PG8_BAR; PG8_SCHED;
            PG8_STAGE(PG8_SB(0, 1), b2 + hstep, voffB);
            PG8_WAIT_V(6); PG8_BAR; PG8_MMA(1, 1, At, B1); PG8_BAR;
            PG8_LDB(B0, 1, 0); PG8_SCHED; PG8_LDA(At, 1, 0); PG8_STAGE(PG8_SA(0, 1), a2 + hstepA, voffA);
            PG8_WAIT_L(8); PG8_BAR; PG8_WAIT_L(0); PG8_MMA(0, 0, At, B0); PG8_BAR; PG8_SCHED;
            PG8_LDB(B1, 1, 1); PG8_STAGE(PG8_SB(1, 0), b3, voffB);
            PG8_BAR; PG8_WAIT_L(0); PG8_MMA(0, 1, At, B1); PG8_BAR;
            PG8_LDA(At, 1, 1); PG8_STAGE(PG8_SA(1, 0), a3, voffA);
            PG8_BAR; PG8_WAIT_L(0); PG8_MMA(1, 0, At, B0); PG8_BAR; PG8_SCHED;
            PG8_STAGE(PG8_SB(1, 1), b3 + hstep, voffB);
            PG8_WAIT_V(6); PG8_BAR; PG8_MMA(1, 1, At, B1); PG8_BAR;
            }
        }
        if constexpr (ALIGN_EPI) { if (wr == 0) PG8_BAR; }
        if constexpr (!Epi::AFTER_DRAIN) { E(acc, cur, wr, wc, fr, fq, lds); S.done(cur); }
        if (!has_next) break;
#pragma unroll
        for (int a = 0; a < 2; ++a)
#pragma unroll
            for (int b = 0; b < 2; ++b)
#pragma unroll
                for (int m = 0; m < 4; ++m)
#pragma unroll
                    for (int n = 0; n < 2; ++n) acc[a][b][m][n] = (f32x4){0.f, 0.f, 0.f, 0.f};
        cur = nxt; cA = nA; cB = nB; ++ui;
        if constexpr (ALIGN_EPI) { if (wr == 1) PG8_BAR; }
    }
    PG8_WAIT_V(0);
    if constexpr (!ALIGN_EPI) { if (wr == 0) PG8_BAR; }
    PG8_BAR;
    if constexpr (Epi::AFTER_DRAIN) { E.fused(acc, cur, wr, wc, fr, fq, lds, wid, lane); S.done(cur); }
#undef PG8_SA
#undef PG8_SB
#undef PG8_STAGE
#undef PG8_LDA
#undef PG8_LDB
#undef PG8_MMA
#undef PG8_WAIT_V
#undef PG8_WAIT_L
#undef PG8_BAR
#undef PG8_SCHED
}
}

struct Ctx { LAS unsigned char* lds; int tid, lane, wave, wg, G; };

__device__ __forceinline__ void transpose_load(float (&tv)[32], const float* W, int N, int item, int lane) {
    const int nblk = N / 32, kb = item / nblk, nb = item % nblk, k0 = 64 * kb, n0 = 32 * nb;
    const float* src = W + (size_t)(k0 + (lane >> 5)) * N + n0 + (lane & 31);
#pragma unroll
    for (int i = 0; i < 32; ++i) tv[i] = src[(size_t)(2 * i) * N];
}
__device__ __forceinline__ void transpose_store(const float (&tv)[32], int K, int N, bf16_t* WT, const float* kscale, int half, LAS float* scr, int item, int lane) {
    const int nblk = N / 32, kb = item / nblk, nb = item % nblk, k0 = 64 * kb, n0 = 32 * nb;
#pragma unroll
    for (int i = 0; i < 32; ++i) { const int kk = 2 * i + (lane >> 5); float v = tv[i]; if (kscale) v *= kscale[k0 + kk]; scr[kk * 33 + (lane & 31)] = v; }
    asm volatile("s_waitcnt lgkmcnt(0)" ::: "memory");
    const int c = lane & 7;
    const int d0 = half ? ((n0 % half) / 128) * 256 + (n0 / half) * 128 + (n0 % 128) : n0;
#pragma unroll
    for (int j = 0; j < 4; ++j) { const int n = (lane >> 3) + 8 * j; const LAS float* s = scr + (8 * c) * 33 + n;
        u32x4 o; o.x = cvt_pk_bf16(s[0 * 33], s[1 * 33]); o.y = cvt_pk_bf16(s[2 * 33], s[3 * 33]); o.z = cvt_pk_bf16(s[4 * 33], s[5 * 33]); o.w = cvt_pk_bf16(s[6 * 33], s[7 * 33]);
        *(u32x4*)(WT + (size_t)(d0 + n) * K + k0 + 8 * c) = o; }
    asm volatile("s_waitcnt lgkmcnt(0)" ::: "memory");
}
__device__ __forceinline__ void prep_mat(const Ctx& C, const float* W, int K, int N, bf16_t* WT, const float* kscale, int half) {
    LAS float* scr = (LAS float*)(C.lds + C.wave * 16384);
    const int gw = C.wg * NWAVES + C.wave, NGW = C.G * NWAVES, items = (K / 64) * (N / 32);
    float ta[32], tb[32];
    int it = gw;
    if (it < items) transpose_load(ta, W, N, it, C.lane);
    while (it < items) {
        const int nit = it + NGW;
        if (nit < items) transpose_load(tb, W, N, nit, C.lane);
        transpose_store(ta, K, N, WT, kscale, half, scr, it, C.lane);
#pragma unroll
        for (int i = 0; i < 32; ++i) ta[i] = tb[i];
        it = nit;
    }
}

__device__ __forceinline__ void x_in_phase(const Ctx& C, const float* src, bf16_t* xn, float* hss) {
    const int gw = C.wg * NWAVES + C.wave, NGW = C.G * NWAVES;
    for (int m = gw; m < M_TOK; m += NGW) {
        const f32x4* xr = (const f32x4*)(src + (size_t)m * DM) + C.lane;
        f32x4 v[8]; float ss = 0.f;
#pragma unroll
        for (int j = 0; j < 8; ++j) { v[j] = xr[64 * j]; ss += (v[j][0] * v[j][0] + v[j][1] * v[j][1]) + (v[j][2] * v[j][2] + v[j][3] * v[j][3]); }
        ss = wave_sum(ss);
        u32x2* o = (u32x2*)(xn + (size_t)m * DM) + C.lane;
#pragma unroll
        for (int j = 0; j < 8; ++j) { u32x2 w; w.x = cvt_pk_bf16(v[j][0], v[j][1]); w.y = cvt_pk_bf16(v[j][2], v[j][3]); o[64 * j] = w; }
        if (C.lane < 32) hss[(size_t)m * 64 + C.lane] = C.lane == 0 ? ss : 0.f;
    }
}
__device__ __forceinline__ void final_norm_phase(const Ctx& C, const bf16_t* xn, const float* hss, const float* gfin, float* outf) {
    const int gw = C.wg * NWAVES + C.wave, NGW = C.G * NWAVES;
    for (int m = gw; m < M_TOK; m += NGW) {
        float s = C.lane < 32 ? hss[(size_t)m * 64 + C.lane] : 0.f;
        const float rs = 1.0f / sqrtf(wave_sum(s) * (1.0f / DM) + EPS);
        const u32x4* xr = (const u32x4*)(xn + (size_t)m * DM) + C.lane;
        f32x4* o = (f32x4*)(outf + (size_t)m * DM); const f32x4* g4 = (const f32x4*)gfin;
#pragma unroll
        for (int j = 0; j < 4; ++j) { const u32x4 r = xr[64 * j]; const int c4 = 2 * (C.lane + 64 * j);
            o[c4] = pg8::bf4lo(r) * rs * g4[c4]; o[c4 + 1] = pg8::bf4hi(r) * rs * g4[c4 + 1]; }
    }
}

__device__ __forceinline__ void s5_prep(const Ctx& C, const float* a_re, const float* a_im, const float* log_dt, const float* b_re, const float* b_im, const float* c_re, const float* c_im,
                                        float* ABAR, bf16_t* BB, bf16_t* CM) {
    const int gt = C.wg * (NWAVES * 64) + C.tid, NT = C.G * NWAVES * 64;
    for (int idx = gt; idx < 128 * 64; idx += NT) {
        const int g = idx >> 6, p = idx & 63;
        const double dt = (double)expf(log_dt[g]);
        const double lr = (double)a_re[idx], li = (double)a_im[idx];
        const double xr = dt * lr; double e = 1.0, term = 1.0;
        for (int k = 1; k <= 14; ++k) { term *= xr / k; e += term; }
        const double x = dt * li; const double kq = rint(x * 0.63661977236758134308); const double r = (x - kq * 1.57079632679489655800) - kq * 6.123233995736766e-17;
        const double r2 = r * r; double sn = r, cs = 1.0, ts = r, tc = 1.0;
        for (int k = 1; k <= 10; ++k) { tc *= -r2 / ((2 * k - 1) * (2 * k)); cs += tc; ts *= -r2 / ((2 * k) * (2 * k + 1)); sn += ts; }
        const int qd = ((int)kq) & 3; double c_ = cs, s_ = sn;
        if (qd == 1) { c_ = -sn; s_ = cs; } else if (qd == 2) { c_ = -cs; s_ = -sn; } else if (qd == 3) { c_ = sn; s_ = -cs; }
        const double abr = e * c_, abi = e * s_;
        ABAR[idx * 2] = (float)abr; ABAR[idx * 2 + 1] = (float)abi;
        const double den = lr * lr + li * li;
        const double qr = ((abr - 1.0) * lr + abi * li) / den, qi = (abi * lr - (abr - 1.0) * li) / den;
        for (int c = 0; c < 16; ++c) {
            const double br = (double)b_re[(size_t)idx * 16 + c], bi = (double)b_im[(size_t)idx * 16 + c];
            const float bbr = (float)(qr * br - qi * bi), bbi = (float)(qr * bi + qi * br);
            BB[((size_t)g * 128 + p) * 16 + c] = (bf16_t)(cvt_pk_bf16(bbr, 0.f) & 0xffffu);
            BB[((size_t)g * 128 + 64 + p) * 16 + c] = (bf16_t)(cvt_pk_bf16(bbi, 0.f) & 0xffffu);
            const float cr = c_re[((size_t)g * 16 + c) * 64 + p], ci = c_im[((size_t)g * 16 + c) * 64 + p];
            *(unsigned*)(CM + ((size_t)g * 16 + c) * 128 + 2 * p) = cvt_pk_bf16(cr, -ci);
        }
    }
}

__device__ __forceinline__ void ws_prep(const Ctx& C, const float* ws, bf16_t* WSB) {
    const int gt = C.wg * (NWAVES * 64) + C.tid, NT = C.G * NWAVES * 64;
    for (int i = gt; i < 16 * 128 * 128 / 2; i += NT) { const int e = 2 * i, t = (e >> 7) & 127, s = e & 127; const f32x2 w = *(const f32x2*)(ws + e);
        *(unsigned*)(WSB + e) = cvt_pk_bf16(s <= t ? w.x : 0.f, s + 1 <= t ? w.y : 0.f); }
}

__device__ __forceinline__ unsigned off_b(unsigned row, unsigned ch) { return 256u * row + 16u * (ch ^ (((row & 3) << 2) | ((row >> 2) & 3))); }
__device__ __forceinline__ unsigned tr_read_addr_16(unsigned lane, unsigned c, unsigned ks, unsigned t) {
    const unsigned g = lane >> 4, q = (lane & 15) >> 2, p = lane & 3;
    return off_b(32 * ks + 8 * g + 4 * t + q, 2 * c + (p >> 1)) + 8 * (p & 1);
}
__device__ __forceinline__ void tr_read8(bf16x8 (&v)[4], const unsigned (&a)[8]) {
    u32x2 r0, r1, r2, r3, r4, r5, r6, r7;
    asm volatile("ds_read_b64_tr_b16 %0, %8\n\tds_read_b64_tr_b16 %1, %9\n\tds_read_b64_tr_b16 %2, %10\n\tds_read_b64_tr_b16 %3, %11\n\t"
                 "ds_read_b64_tr_b16 %4, %12\n\tds_read_b64_tr_b16 %5, %13\n\tds_read_b64_tr_b16 %6, %14\n\tds_read_b64_tr_b16 %7, %15\n\ts_waitcnt lgkmcnt(0)"
                 : "=&v"(r0), "=&v"(r1), "=&v"(r2), "=&v"(r3), "=&v"(r4), "=&v"(r5), "=&v"(r6), "=&v"(r7)
                 : "v"(a[0]), "v"(a[1]), "v"(a[2]), "v"(a[3]), "v"(a[4]), "v"(a[5]), "v"(a[6]), "v"(a[7]) : "memory");
    v[0] = __builtin_bit_cast(bf16x8, (u32x4){r0.x, r0.y, r1.x, r1.y}); v[1] = __builtin_bit_cast(bf16x8, (u32x4){r2.x, r2.y, r3.x, r3.y});
    v[2] = __builtin_bit_cast(bf16x8, (u32x4){r4.x, r4.y, r5.x, r5.y}); v[3] = __builtin_bit_cast(bf16x8, (u32x4){r6.x, r6.y, r7.x, r7.y});
}
__device__ __forceinline__ void sgu_phase(const Ctx& C, const bf16_t* Z1, const float* VSS, const float* gv, const bf16_t* WSB, const float* bs, bf16_t* Gout) {
    LAS unsigned char* Vs = C.lds;
    LAS float* rsv = (LAS float*)(C.lds + 32768);
    const int lane = C.lane, w = C.wave, fr = lane & 15, g4 = lane >> 4;
    const unsigned ldsbase = (unsigned)(uintptr_t)Vs;
    const int tb = w >> 1, dh = w & 1;
    const int ch = C.tid & 15, srow = C.tid >> 4;
    for (int task = C.wg; task < M_TOK / CHK; task += C.G) {
        const int tok0 = task * CHK;
        __syncthreads();
        if (C.tid < 128) { const f32x4* p = (const f32x4*)(VSS + (size_t)(tok0 + C.tid) * 32); float s = 0.f;
#pragma unroll
            for (int i = 0; i < 8; ++i) { const f32x4 q = p[i]; s += (q[0] + q[1]) + (q[2] + q[3]); }
            rsv[C.tid] = 1.0f / sqrtf(s * (1.0f / DM) + EPS); }
        u32x4 vraw[4];
#pragma unroll
        for (int ps = 0; ps < 4; ++ps) vraw[ps] = *(const u32x4*)(Z1 + (size_t)(tok0 + ps * 32 + srow) * 4096 + 2048 + 8 * ch);
        __syncthreads();
        for (int h = 0; h < 16; ++h) {
            {
                const f32x4 ga = *(const f32x4*)(gv + 128 * h + 8 * ch), gb = *(const f32x4*)(gv + 128 * h + 8 * ch + 4);
#pragma unroll
                for (int ps = 0; ps < 4; ++ps) { const int s = ps * 32 + srow; const u32x4 raw = vraw[ps]; const float r = rsv[s];
                    u32x4 o; o.x = cvt_pk_bf16(bflo(raw.x) * r * ga[0], bfhi(raw.x) * r * ga[1]); o.y = cvt_pk_bf16(bflo(raw.y) * r * ga[2], bfhi(raw.y) * r * ga[3]);
                    o.z = cvt_pk_bf16(bflo(raw.z) * r * gb[0], bfhi(raw.z) * r * gb[1]); o.w = cvt_pk_bf16(bflo(raw.w) * r * gb[2], bfhi(raw.w) * r * gb[3]);
                    *(LAS u32x4*)(Vs + off_b(s, ch)) = o; }
            }
            if (h + 1 < 16) {
#pragma unroll
                for (int ps = 0; ps < 4; ++ps) vraw[ps] = *(const u32x4*)(Z1 + (size_t)(tok0 + ps * 32 + srow) * 4096 + 2048 + 128 * (h + 1) + 8 * ch);
            }
            bf16x8 wf[4][2];
#pragma unroll
            for (int kk = 0; kk < 4; ++kk)
#pragma unroll
                for (int mt = 0; mt < 2; ++mt) wf[kk][mt] = *(const bf16x8*)(WSB + ((size_t)h * 128 + 32 * tb + 16 * mt + fr) * 128 + 32 * (kk <= tb ? kk : tb) + 8 * g4);
            u32x2 uu[2][4];
#pragma unroll
            for (int mt = 0; mt < 2; ++mt)
#pragma unroll
                for (int nt = 0; nt < 4; ++nt) uu[mt][nt] = *(const u32x2*)(Z1 + (size_t)(tok0 + 32 * tb + 16 * mt + fr) * 4096 + 128 * h + 64 * dh + 16 * nt + 4 * g4);
            __syncthreads();
            f32x4 acc[2][4];
#pragma unroll
            for (int a = 0; a < 2; ++a)
#pragma unroll
                for (int b = 0; b < 4; ++b) acc[a][b] = (f32x4){0.f, 0.f, 0.f, 0.f};
#pragma unroll
            for (int kk = 0; kk < 4; ++kk) {
                if (kk <= tb) {
                    unsigned ad[8]; bf16x8 vf[4];
#pragma unroll
                    for (int nt = 0; nt < 4; ++nt) { ad[2 * nt] = ldsbase + tr_read_addr_16(lane, 4 * dh + nt, kk, 0); ad[2 * nt + 1] = ldsbase + tr_read_addr_16(lane, 4 * dh + nt, kk, 1); }
                    tr_read8(vf, ad);
#pragma unroll
                    for (int nt = 0; nt < 4; ++nt)
#pragma unroll
                        for (int mt = 0; mt < 2; ++mt) acc[mt][nt] = __builtin_amdgcn_mfma_f32_16x16x32_bf16(vf[nt], wf[kk][mt], acc[mt][nt], 0, 0, 0);
                }
            }
#pragma unroll
            for (int mt = 0; mt < 2; ++mt) { const int t = 32 * tb + 16 * mt + fr; const float bias = bs[h * 128 + t];
#pragma unroll
                for (int nt = 0; nt < 4; ++nt) { const int d = 128 * h + 64 * dh + 16 * nt + 4 * g4; const u32x2 u2 = uu[mt][nt];
                    u32x2 o; o.x = cvt_pk_bf16(bflo(u2.x) * (acc[mt][nt][0] + bias), bfhi(u2.x) * (acc[mt][nt][1] + bias)); o.y = cvt_pk_bf16(bflo(u2.y) * (acc[mt][nt][2] + bias), bfhi(u2.y) * (acc[mt][nt][3] + bias));
                    *(u32x2*)(Gout + (size_t)(tok0 + t) * DM + d) = o; } }
            __syncthreads();
        }
    }
}

constexpr int S5_SUB = 16, S5_NS = SEQ / S5_SUB, S5_HP = 272;
__device__ __forceinline__ void s5_phase(const Ctx& C, const bf16_t* U, bf16_t* Gout, const float* ABAR, const bf16_t* BB, const bf16_t* CM, const float* Dsk) {
    const int lane = C.lane, fr = lane & 15, g4 = lane >> 4, pw = C.wave & 3, role = C.wave >> 2;
    for (int task = C.wg; task < NBATCH * 32; task += C.G) {
        const int b = task >> 5, g = (task & 31) * 4 + pw;
        const size_t tokb = (size_t)b * SEQ;
        LAS unsigned char* bub = C.lds + pw * 16384;
        LAS unsigned char* hb = C.lds + 65536 + pw * (2 * S5_SUB * S5_HP);
        __syncthreads();
        if (role == 1) {
            bf16x8 bfr[8], cfr[4], dfr; const bf16x8 zero8 = (bf16x8){0, 0, 0, 0, 0, 0, 0, 0};
#pragma unroll
            for (int n = 0; n < 8; ++n) bfr[n] = g4 < 2 ? *(const bf16x8*)(BB + ((size_t)g * 128 + 16 * n + fr) * 16 + 8 * g4) : zero8;
#pragma unroll
            for (int kk = 0; kk < 4; ++kk) cfr[kk] = *(const bf16x8*)(CM + ((size_t)g * 16 + fr) * 128 + 32 * kk + 8 * g4);
            { const unsigned dv = cvt_pk_bf16(Dsk[16 * g + fr], 0.f) & 0xffffu; dfr = zero8;
#pragma unroll
              for (int j = 0; j < 8; ++j) if (g4 < 2 && 8 * g4 + j == fr) dfr[j] = (short)dv; }
            const bf16_t* up = U + tokb * DM + 16 * g + 8 * g4;
            const LAS unsigned char* uring = C.lds + 100352 + pw * 4096;
            const unsigned uoff = (unsigned)(2 * fr + g4) * 16u;
            LDS_BARRIER();
            for (int i = -1; i <= S5_NS; ++i) {
                const bf16x8 uf = g4 < 2 ? *(const LAS bf16x8*)(uring + ((i + 1) & 7) * 512 + uoff) : zero8;
                const bf16x8 us = g4 < 2 ? *(const LAS bf16x8*)(uring + ((i - 1) & 7) * 512 + uoff) : zero8;
                const LAS unsigned char* src = hb + ((i - 1) & 1) * (S5_SUB * S5_HP) + fr * S5_HP + 16 * g4;
                bf16x8 hf[4];
#pragma unroll
                for (int kk = 0; kk < 4; ++kk) hf[kk] = *(const LAS bf16x8*)(src + 64 * kk);
                LAS unsigned char* dst = bub + ((i + 1) & 1) * 4096;
                f32x4 a[8];
#pragma unroll
                for (int n = 0; n < 8; ++n) a[n] = __builtin_amdgcn_mfma_f32_16x16x32_bf16(uf, bfr[n], (f32x4){0.f, 0.f, 0.f, 0.f}, 0, 0, 0);
                f32x4 y1 = __builtin_amdgcn_mfma_f32_16x16x32_bf16(dfr, us, (f32x4){0.f, 0.f, 0.f, 0.f}, 0, 0, 0);
                f32x4 y2 = __builtin_amdgcn_mfma_f32_16x16x32_bf16(cfr[2], hf[2], (f32x4){0.f, 0.f, 0.f, 0.f}, 0, 0, 0);
                y1 = __builtin_amdgcn_mfma_f32_16x16x32_bf16(cfr[0], hf[0], y1, 0, 0, 0);
                y2 = __builtin_amdgcn_mfma_f32_16x16x32_bf16(cfr[3], hf[3], y2, 0, 0, 0);
                y1 = __builtin_amdgcn_mfma_f32_16x16x32_bf16(cfr[1], hf[1], y1, 0, 0, 0);
#pragma unroll
                for (int n = 0; n < 4; ++n) { u32x4 w;
                    w.x = cvt_pk_bf16_c(a[n][0], a[n + 4][0]); w.y = cvt_pk_bf16_c(a[n][1], a[n + 4][1]); w.z = cvt_pk_bf16_c(a[n][2], a[n + 4][2]); w.w = cvt_pk_bf16_c(a[n][3], a[n + 4][3]);
                    *(LAS u32x4*)(dst + ((g4 * 64) + 16 * n + fr) * 16) = w; }
                const f32x4 y = y1 + y2;
                if (i >= 1) {
                    u32x2 o; o.x = cvt_pk_bf16_c(gelu_f(y[0]), gelu_f(y[1])); o.y = cvt_pk_bf16_c(gelu_f(y[2]), gelu_f(y[3]));
                    *(u32x2*)(Gout + (tokb + 16 * (i - 1) + fr) * DM + 16 * g + 4 * g4) = o;
                }
                LDS_BARRIER();
            }
        } else {
            const f32x2 ab = *(const f32x2*)(ABAR + ((size_t)g * 64 + lane) * 2);
            float hr = 0.f, hi = 0.f;
            LAS unsigned char* uring = C.lds + 100352 + pw * 4096;
            const bf16_t* usrc = U + (tokb + 16 * (lane >> 5) + ((lane & 31) >> 1)) * DM + 16 * g + 8 * (lane & 1);
#define S5_DMA(s0) __builtin_amdgcn_global_load_lds((const unsigned*)(usrc + (size_t)(16 * (s0)) * DM), (LAS unsigned*)(uring + ((s0) & 7) * 512), 16, 0, 0)
            S5_DMA(0); S5_DMA(2);
            asm volatile("s_waitcnt vmcnt(0)" ::: "memory");
            LDS_BARRIER();
            for (int i = -1; i <= S5_NS; ++i) {
                if ((i & 1) && i + 5 < S5_NS) S5_DMA(i + 5);
                if (i >= 0 && i < S5_NS) {
                    const LAS unsigned char* src = bub + (i & 1) * 4096 + lane * 16;
                    LAS unsigned char* dst = hb + (i & 1) * (S5_SUB * S5_HP) + lane * 4;
                    u32x4 bq[S5_SUB / 4];
#pragma unroll
                    for (int q = 0; q < S5_SUB / 4; ++q) bq[q] = *(const LAS u32x4*)(src + q * 1024);
#pragma unroll
                    for (int t = 0; t < S5_SUB; ++t) {
                        const unsigned bw = bq[t >> 2][t & 3];
                        const float nr = ab.x * hr - ab.y * hi + bflo(bw), ni = ab.x * hi + ab.y * hr + bfhi(bw);
                        hr = nr; hi = ni;
                        *(LAS unsigned*)(dst + t * S5_HP) = cvt_pk_bf16(hr, hi);
                    }
                }
                if (i + 7 < S5_NS) asm volatile("s_waitcnt vmcnt(1)" ::: "memory");
                else asm volatile("s_waitcnt vmcnt(0)" ::: "memory");
                LDS_BARRIER();
            }
#undef S5_DMA
        }
    }
}

__device__ __forceinline__ void fixup_phase(const Ctx& C, const float* ZH, const float* cw, const float* cb, bf16_t* HID) {
    const int gt = C.wg * (NWAVES * 64) + C.tid, NT = C.G * NWAVES * 64;
    const f32x4 zero4 = (f32x4){0.f, 0.f, 0.f, 0.f};
    for (int idx = gt; idx < 128 * 4 * (FF / 4); idx += NT) {
        const int c = 4 * (idx % (FF / 4)), rr = (idx / (FF / 4)) & 3, pm = idx / (4 * (FF / 4));
        const bool first = (pm & 15) == 0;
        const int rt = (rr < 2) ? rr : rr + 2;
        f32x4 o[2];
#pragma unroll
        for (int hf = 0; hf < 2; ++hf) { const int cc = c + hf * FF; const float* zb = ZH + (size_t)(pm * 8) * FF2 + cc;
            const f32x4 zt = *(const f32x4*)(zb + (size_t)rt * FF2);
            f32x4 z1, z2;
            if (rr == 0) { z1 = first ? zero4 : *(const f32x4*)(zb - (size_t)1 * FF2); z2 = first ? zero4 : *(const f32x4*)(zb - (size_t)2 * FF2); }
            else if (rr == 1) { z1 = *(const f32x4*)zb; z2 = first ? zero4 : *(const f32x4*)(zb - (size_t)1 * FF2); }
            else { z1 = *(const f32x4*)(zb + (size_t)(rt - 1) * FF2); z2 = *(const f32x4*)(zb + (size_t)(rt - 2) * FF2); }
            o[hf] = *(const f32x4*)(cb + cc) + *(const f32x4*)(cw + 2 * FF2 + cc) * zt + *(const f32x4*)(cw + FF2 + cc) * z1 + *(const f32x4*)(cw + cc) * z2; }
        u32x2 w; w.x = cvt_pk_bf16(o[0][0] * sigmoid_f(o[0][0]) * o[1][0], o[0][1] * sigmoid_f(o[0][1]) * o[1][1]); w.y = cvt_pk_bf16(o[0][2] * sigmoid_f(o[0][2]) * o[1][2], o[0][3] * sigmoid_f(o[0][3]) * o[1][3]);
        *(u32x2*)(HID + (size_t)(pm * 256 + (rr & 1) + (rr >> 1) * 128) * FF + c) = w;
    }
}

struct Args { const float* in[23]; float* out; unsigned char* ws; int ph_lo, ph_hi; };
#ifndef DUPST
#define DUPST (-1)
#endif
constexpr int PPL = 6 + (DUPST >= 0 ? 1 : 0);
constexpr int N_PHASES = 2 + PPL * DEPTH;
#ifndef PHMASK
#define PHMASK 0xFFFF
#endif
#define EN(k) (((PHMASK) >> (k)) & 1)
#ifndef DUP
#define DUP 0
#endif
#define DUPN(k) ((((DUP) >> (k)) & 1) ? 2 : 1)

template <class Epi> __device__ __forceinline__ void run_gemm(const Ctx& C, const bf16_t* A, const bf16_t* Bt, int N, int K, Epi& E, const float* hss, int np) {
    pg8::Gemm g{A, Bt, M_TOK, N, K}; pg8::StaticOrder S; S.init(M_TOK, N, C.G, C.wg, hss ? 8 : 4);
    pg8::Unit u0, u1, t; S.next(0, u0); u1 = u0; for (int i = 1; S.next(i, t); ++i) u1 = t;
    {
        LAS float* RS = (LAS float*)(C.lds + RS_OFF);
        float rs = 1.0f;
        if (hss) { const int row = (C.tid < 256 ? u0.pm : u1.pm) * 256 + (C.tid & 255); const f32x4* p4 = (const f32x4*)(hss + (size_t)row * 64); float s = 0.f;
            for (int i = 0; i < np / 4; ++i) { const f32x4 q = p4[i]; s += (q[0] + q[1]) + (q[2] + q[3]); }
            rs = 1.0f / sqrtf(s * (1.0f / DM) + EPS); }
        RS[C.tid] = rs;
        __syncthreads();
    }
    E.pm0 = u0.pm;
    pg8::gemm_phase<Epi, pg8::StaticOrder, true, true>(C.lds, g, S, E, C.tid);
}

__device__ __forceinline__ unsigned long long ld_ptr(const LAS unsigned long long* p) {
    const unsigned long long v = *p; const unsigned lo = __builtin_amdgcn_readfirstlane((unsigned)v), hi = __builtin_amdgcn_readfirstlane((unsigned)(v >> 32));
    return ((unsigned long long)hi << 32) | lo;
}
__global__ void __launch_bounds__(NWAVES * 64, 2) mk_fwd(Args a) {
    extern __shared__ __attribute__((aligned(16))) unsigned char lds_raw[];
    unsigned char* ws = a.ws;
    float* H = a.out;
    bf16_t* XN = (bf16_t*)(ws + WS_XN); bf16_t* Z1 = (bf16_t*)(ws + WS_Z1); bf16_t* GB = (bf16_t*)(ws + WS_G); bf16_t* HID = (bf16_t*)(ws + WS_HID);
    float* VSS = (float*)(ws + WS_VSS); float* ZH = (float*)(ws + WS_ZH); float* HSS = (float*)(ws + WS_HSS);
    unsigned char* WB = ws + WS_W;

    LAS unsigned long long* PT = (LAS unsigned long long*)((LAS unsigned char*)lds_raw + MISC_OFF + 64);
    if (threadIdx.x == 0) {
#pragma unroll
        for (int i = 0; i < 23; ++i) PT[i] = (unsigned long long)a.in[i];
    }
#define IN(i) ((const float*)ld_ptr(PT + (i)))
    volatile LAS unsigned* MISC = (volatile LAS unsigned*)((LAS unsigned char*)lds_raw + MISC_OFF);
    if (threadIdx.x < 2) MISC[threadIdx.x] = 0u;
    __syncthreads();
    XcdBarrier bar; bar.bar = (unsigned*)ws; bar.x = 0; bar.st = MISC;
    if (a.ph_hi - a.ph_lo > 1) bar = xcd_barrier_post((unsigned*)ws, MISC);
    for (int ph = a.ph_lo; ph < a.ph_hi; ++ph) {
        int tid_l = threadIdx.x; asm volatile("" : "+v"(tid_l));
        Ctx C; C.lds = (LAS unsigned char*)lds_raw; C.tid = tid_l; C.lane = C.tid & 63; C.wave = __builtin_amdgcn_readfirstlane(C.tid >> 6); C.wg = blockIdx.x; C.G = gridDim.x;
        if (ph == 0) { if constexpr (EN(0)) { for (int dup = 0; dup < DUPN(0); ++dup) {
            for (int j = 0; j < 2; ++j) {
                prep_mat(C, IN(3) + (size_t)j * DM * 4096, DM, 4096, (bf16_t*)(WB + W_AIN + j * S_AIN), IN(1) + (2 * j) * DM, 0);
                prep_mat(C, IN(7) + (size_t)j * DM * DM, DM, DM, (bf16_t*)(WB + W_AOUT + j * S_AOUT), nullptr, 0);
                prep_mat(C, IN(8) + (size_t)j * DM * DM, DM, DM, (bf16_t*)(WB + W_BIN + j * S_BIN), IN(1) + (2 * j + 1) * DM, 0);
                prep_mat(C, IN(17) + (size_t)j * DM * 4096, DM, 4096, (bf16_t*)(WB + W_GLU + j * S_GLU), nullptr, 2048);
                s5_prep(C, IN(9) + j * 8192, IN(10) + j * 8192, IN(11) + j * 128, IN(12) + (size_t)j * 131072, IN(13) + (size_t)j * 131072, IN(14) + (size_t)j * 131072, IN(15) + (size_t)j * 131072,
                        (float*)(ws + WS_ABAR) + j * 16384, (bf16_t*)(ws + WS_BB) + (size_t)j * 262144, (bf16_t*)(ws + WS_CM) + (size_t)j * 262144);
                ws_prep(C, IN(5) + (size_t)j * 262144, (bf16_t*)(ws + WS_WSB) + (size_t)j * 262144);
            }
            for (int i = 0; i < DEPTH; ++i) {
                prep_mat(C, IN(18) + (size_t)i * DM * FF2, DM, FF2, (bf16_t*)(WB + W_UP + i * S_UP), IN(2) + i * DM, FF);
                prep_mat(C, IN(21) + (size_t)i * FF * DM, FF, DM, (bf16_t*)(WB + W_DOWN + i * S_DOWN), nullptr, 0);
            }
            x_in_phase(C, IN(0), XN, HSS);
        } } } else if (ph == N_PHASES - 1) {
            if constexpr (EN(11)) final_norm_phase(C, XN, HSS, IN(22), H);
        } else {
            const int L = (ph - 1) / PPL, pos = (ph - 1) % PPL, st = (DUPST >= 0 && pos > DUPST) ? pos - 1 : pos, j = L >> 1; const bool isA = (L & 1) == 0;
            const float* hss_in = HSS;
            if (st == 0) {
                if (isA) { if constexpr (EN(1)) { pg8::EpiGeluSS E{Z1, VSS, 0}; run_gemm(C, XN, (const bf16_t*)(WB + W_AIN + j * S_AIN), 4096, DM, E, hss_in, 32); } }
                else { if constexpr (EN(2)) { pg8::EpiPlainBf16 E{Z1, DM, 0}; run_gemm(C, XN, (const bf16_t*)(WB + W_BIN + j * S_BIN), DM, DM, E, hss_in, 32); } }
            } else if (st == 1) {
                if (isA) { if constexpr (EN(3)) sgu_phase(C, Z1, VSS, IN(4) + j * DM, (const bf16_t*)(ws + WS_WSB) + (size_t)j * 262144, IN(6) + j * 2048, GB); }
                else if constexpr (EN(4)) s5_phase(C, Z1, GB, (const float*)(ws + WS_ABAR) + j * 16384, (const bf16_t*)(ws + WS_BB) + (size_t)j * 262144, (const bf16_t*)(ws + WS_CM) + (size_t)j * 262144, IN(16) + j * DM);
            } else if (st == 2) {
                if (isA) { if constexpr (EN(5)) { pg8::EpiRes E{XN, HSS, 0}; run_gemm(C, GB, (const bf16_t*)(WB + W_AOUT + j * S_AOUT), DM, DM, E, nullptr, 0); } }
                else { if constexpr (EN(6)) { pg8::EpiGlu E{XN, HSS, 0}; run_gemm(C, GB, (const bf16_t*)(WB + W_GLU + j * S_GLU), 4096, DM, E, nullptr, 0); } }
            } else if (st == 3) {
                if constexpr (EN(8)) { pg8::EpiUp E{HID, ZH, IN(19) + (size_t)L * 3 * FF2, IN(20) + (size_t)L * FF2, 0}; run_gemm(C, XN, (const bf16_t*)(WB + W_UP + L * S_UP), FF2, DM, E, HSS, isA ? 32 : 64); }
            } else if (st == 4) {
                if constexpr (EN(9)) fixup_phase(C, ZH, IN(19) + (size_t)L * 3 * FF2, IN(20) + (size_t)L * FF2, HID);
            } else {
                if constexpr (EN(10)) { pg8::EpiRes E{XN, HSS, 0}; run_gemm(C, HID, (const bf16_t*)(WB + W_DOWN + L * S_DOWN), DM, FF, E, nullptr, 0); }
            }
        }
        if (ph + 1 < a.ph_hi) { for (int dup = 0; dup < DUPN(7); ++dup) {
            if (a.ph_hi > 4096) { __syncthreads(); cg::this_grid().sync(); }
            else xcd_barrier(bar); } }
    }
}

#undef IN
extern "C" void kernel_launch(void* const* d_in, const int* in_sizes, int n_in, void* d_out, int out_size, void* d_ws, size_t ws_size, hipStream_t stream) {
    static int grid = 0;
    if (grid == 0) {
        if (n_in != 23 || out_size != M_TOK * DM || ws_size < WS_END) { fprintf(stderr, "kernel_launch: unexpected shapes (n_in %d out %d ws %zu)\n", n_in, out_size, ws_size); grid = -1; return; }
        int dev = 0, cus = 0, per_cu = 0;
        hipGetDevice(&dev); hipDeviceGetAttribute(&cus, hipDeviceAttributeMultiprocessorCount, dev);
        if (hipFuncSetAttribute((const void*)mk_fwd, hipFuncAttributeMaxDynamicSharedMemorySize, LDS_BYTES) != hipSuccess) { fprintf(stderr, "kernel_launch: hipFuncSetAttribute failed\n"); grid = -1; return; }
        if (hipOccupancyMaxActiveBlocksPerMultiprocessor(&per_cu, (const void*)mk_fwd, NWAVES * 64, LDS_BYTES) != hipSuccess || per_cu < 1) { fprintf(stderr, "kernel_launch: occupancy query says %d\n", per_cu); per_cu = 1; }
        (void)hipGetLastError();
        grid = cus;
    }
    if (grid < 0) return;
    if (hipMemsetAsync(d_ws, 0, 65536, stream) != hipSuccess) { fprintf(stderr, "kernel_launch: memset failed\n"); return; }
    Args a{};
    for (int i = 0; i < 23; ++i) a.in[i] = (const float*)d_in[i];
    a.out = (float*)d_out; a.ws = (unsigned char*)d_ws;
#if MK_MULTI
    for (int p = 0; p < N_PHASES; ++p) { a.ph_lo = p; a.ph_hi = p + 1; hipLaunchKernelGGL(mk_fwd, dim3(grid), dim3(NWAVES * 64), LDS_BYTES, stream, a); }
#else
    a.ph_lo = 0; a.ph_hi = N_PHASES;
    void* args[] = {&a};
    hipError_t e = hipLaunchCooperativeKernel((const void*)mk_fwd, dim3(grid), dim3(NWAVES * 64), args, LDS_BYTES, stream);
    if (e != hipSuccess) fprintf(stderr, "kernel_launch: cooperative launch failed: %s (grid %d)\n", hipGetErrorString(e), grid);
#endif
}
```

```cpp
#include <hip/hip_runtime.h>
#include <hip/hip_cooperative_groups.h>
#include <cstdio>
#include <cstdint>
namespace cg = cooperative_groups;

#ifndef MK_MULTI
#define MK_MULTI 0
#endif

constexpr int M_TOK = 32768, DM = 2048, SEQ = 4096, NBATCH = 8, CHK = 128, FF = 5632, FF2 = 11264, DEPTH = 4;
constexpr float EPS = 1e-6f;
constexpr int NWAVES = 8;
constexpr int LDS_BYTES = 147456;
constexpr int HALO_OFF = 131072, MISC_OFF = 139264, RS_OFF = 139520;

constexpr size_t MiB = 1u << 20;
constexpr size_t WS_ABAR = 1 * MiB;
constexpr size_t WS_BB   = 2 * MiB;
constexpr size_t WS_CM   = 3 * MiB;
constexpr size_t WS_VSS  = 5 * MiB;
constexpr size_t WS_ZH   = 9 * MiB;
constexpr size_t WS_HSS  = 904 * MiB;
constexpr size_t WS_WSB  = 31 * MiB;
constexpr size_t WS_W    = 32 * MiB;
constexpr size_t W_AIN = 0, W_AOUT = 32 * MiB, W_BIN = 48 * MiB, W_GLU = 64 * MiB, W_UP = 96 * MiB, W_DOWN = 272 * MiB;
constexpr size_t S_AIN = 16 * MiB, S_AOUT = 8 * MiB, S_BIN = 8 * MiB, S_GLU = 16 * MiB, S_UP = 44 * MiB, S_DOWN = 22 * MiB;
constexpr size_t WS_XN   = 392 * MiB;
constexpr size_t WS_Z1   = 520 * MiB;
constexpr size_t WS_G    = 776 * MiB;
constexpr size_t WS_HID  = 520 * MiB;
constexpr size_t WS_H2   = 912 * MiB;
constexpr size_t WS_END  = 912 * MiB;
static_assert(W_DOWN + 4 * S_DOWN == 360 * MiB && WS_W + 360 * MiB == WS_XN, "weights map");
static_assert(WS_HID + (size_t)M_TOK * FF * 2 <= WS_HSS, "hid map");

#define LAS __attribute__((address_space(3)))
typedef unsigned short bf16_t;
typedef short bf16x8 __attribute__((ext_vector_type(8)));
typedef float f32x4 __attribute__((ext_vector_type(4)));
typedef float f32x2 __attribute__((ext_vector_type(2)));
typedef unsigned u32x4 __attribute__((ext_vector_type(4)));
typedef unsigned u32x2 __attribute__((ext_vector_type(2)));

__device__ __forceinline__ unsigned cvt_pk_bf16(float lo, float hi) { unsigned r; asm volatile("v_cvt_pk_bf16_f32 %0, %1, %2" : "=v"(r) : "v"(lo), "v"(hi)); return r; }
typedef __bf16 bf16x2_t __attribute__((ext_vector_type(2)));
__device__ __forceinline__ unsigned cvt_pk_bf16_c(float lo, float hi) { f32x2 v = {lo, hi}; bf16x2_t b = __builtin_convertvector(v, bf16x2_t); return __builtin_bit_cast(unsigned, b); }
__device__ __forceinline__ float bf2f(unsigned short b) { return __builtin_bit_cast(float, ((unsigned)b) << 16); }
__device__ __forceinline__ float bflo(unsigned w) { return __builtin_bit_cast(float, w << 16); }
__device__ __forceinline__ float bfhi(unsigned w) { return __builtin_bit_cast(float, w & 0xffff0000u); }
__device__ __forceinline__ float gelu_f(float x) {
    const float t = x * (1.0f + 0.044715f * x * x) * (-1.5957691216057308f * 1.4426950408889634f);
    return x * __builtin_amdgcn_rcpf(1.0f + __builtin_amdgcn_exp2f(t));
}
__device__ __forceinline__ f32x4 gelu4(f32x4 v) { return (f32x4){gelu_f(v[0]), gelu_f(v[1]), gelu_f(v[2]), gelu_f(v[3])}; }
__device__ __forceinline__ float sigmoid_f(float x) { return __builtin_amdgcn_rcpf(1.0f + __builtin_amdgcn_exp2f(-1.4426950408889634f * x)); }
__device__ __forceinline__ float wave_sum(float v) {
#pragma unroll
    for (int o = 1; o < 64; o <<= 1) v += __shfl_xor(v, o);
    return v;
}
__device__ __forceinline__ float dpp_ror1(float x) { return __builtin_bit_cast(float, __builtin_amdgcn_update_dpp(0, __builtin_bit_cast(int, x), 0x121, 0xF, 0xF, false)); }
__device__ __forceinline__ float dpp_ror2(float x) { return __builtin_bit_cast(float, __builtin_amdgcn_update_dpp(0, __builtin_bit_cast(int, x), 0x122, 0xF, 0xF, false)); }
__device__ __forceinline__ float dpp_shr1_old(float old, float x) { return __builtin_bit_cast(float, __builtin_amdgcn_update_dpp(__builtin_bit_cast(int, old), __builtin_bit_cast(int, x), 0x111, 0xF, 0xF, false)); }
__device__ __forceinline__ float dpp_shr2_old(float old, float x) { return __builtin_bit_cast(float, __builtin_amdgcn_update_dpp(__builtin_bit_cast(int, old), __builtin_bit_cast(int, x), 0x112, 0xF, 0xF, false)); }
template <int CTRL> __device__ __forceinline__ float dpp_z(float x) { return __builtin_bit_cast(float, __builtin_amdgcn_update_dpp(0, __builtin_bit_cast(int, x), CTRL, 0xF, 0xF, true)); }
#define LDS_BARRIER() do { asm volatile("s_waitcnt lgkmcnt(0)" ::: "memory"); __builtin_amdgcn_s_barrier(); asm volatile("" ::: "memory"); } while (0)

#define XB_TMO      128
#define XB_XCNT(j)  (256  + 64 * (j))
#define XB_XSUB(j)  (1280 + 64 * (j))
#define XB_XGEN(j)  (2304 + 64 * (j))
#define XB_TOP      3328
#define XB_TOPGEN   3392
#define XCD_BAR_WORDS 3456
#define XB_SPIN_CAP (1u << 18)

__device__ __forceinline__ unsigned xb_ld(unsigned* p)              { return __hip_atomic_load(p, __ATOMIC_RELAXED, __HIP_MEMORY_SCOPE_AGENT); }
__device__ __forceinline__ unsigned xb_add(unsigned* p, unsigned v) { return __hip_atomic_fetch_add(p, v, __ATOMIC_RELAXED, __HIP_MEMORY_SCOPE_AGENT); }
__device__ __forceinline__ unsigned xb_xcc_id() { return (unsigned)__builtin_amdgcn_s_getreg((3 << 11) | 20) & 0xFu; }
#define XB_SPIN(cond, bar) do { unsigned _sp = 0; while (cond) { __builtin_amdgcn_s_sleep(1); \
    if ((++_sp & 255u) == 0u) { if (xb_ld(&(bar)[XB_TMO])) break; if (_sp > XB_SPIN_CAP) { atomicAdd(&(bar)[XB_TMO], 1u); break; } } } } while (0)

struct XcdBarrier {
    unsigned* bar; unsigned x;
    volatile LAS unsigned* st;
};

__device__ __forceinline__ XcdBarrier xcd_barrier_post(unsigned* bar, volatile LAS unsigned* st) {
    XcdBarrier b; b.bar = bar; b.x = xb_xcc_id(); b.st = st;
    if (threadIdx.x == 0) (void)xb_add(&bar[XB_XCNT(b.x)], 1u);
    return b;
}
__device__ __forceinline__ void xcd_barrier_complete(unsigned* bar, unsigned x, unsigned& nloc, unsigned& nx) {
    const unsigned G = gridDim.x * gridDim.y * gridDim.z;
    unsigned sum, cnt, mine, sp = 0u;
    for (;;) {
        sum = 0u; cnt = 0u; mine = 0u;
#pragma unroll
        for (unsigned j = 0; j < 16; ++j) { const unsigned c = xb_ld(&bar[XB_XCNT(j)]); sum += c; cnt += (c > 0u) ? 1u : 0u; mine = (j == x) ? c : mine; }
        if (sum == G) break;
        __builtin_amdgcn_s_sleep(1);
        if ((++sp & 255u) == 0u) { if (xb_ld(&bar[XB_TMO])) break; if (sp > XB_SPIN_CAP) { atomicAdd(&bar[XB_TMO], 1u); break; } }
    }
    nloc = mine > 0u ? mine : 1u; nx = cnt > 0u ? cnt : 1u;
}

__device__ __forceinline__ void xcd_barrier(const XcdBarrier& b) {
    asm volatile("s_waitcnt vmcnt(0)" ::: "memory");
    __syncthreads();
    if (threadIdx.x == 0) {
        unsigned* bar = b.bar;
        __builtin_amdgcn_s_waitcnt(0);
        unsigned nloc = b.st[0], nx = b.st[1];
        if (nloc == 0u) { xcd_barrier_complete(bar, b.x, nloc, nx); b.st[0] = nloc; b.st[1] = nx; }
        const unsigned old = xb_add(&bar[XB_XSUB(b.x)], 1u);
        const unsigned gen = old / nloc;
        if (old + 1u == (gen + 1u) * nloc) {
            __builtin_amdgcn_fence(__ATOMIC_RELEASE, "agent");
            asm volatile("s_waitcnt vmcnt(0)" ::: "memory");
            const unsigned og = xb_add(&bar[XB_TOP], 1u);
            const unsigned tg = og / nx;
            if (og + 1u == (tg + 1u) * nx) xb_add(&bar[XB_TOPGEN], 1u);
            else XB_SPIN(xb_ld(&bar[XB_TOPGEN]) == tg, bar);
            __builtin_amdgcn_fence(__ATOMIC_ACQUIRE, "agent");
            xb_add(&bar[XB_XGEN(b.x)], 1u);
            asm volatile("s_waitcnt vmcnt(0)" ::: "memory");
        } else {
            XB_SPIN(xb_ld(&bar[XB_XGEN(b.x)]) == gen, bar);
            __builtin_amdgcn_fence(__ATOMIC_ACQUIRE, "agent");
            asm volatile("s_waitcnt vmcnt(0)" ::: "memory");
        }
    }
    __syncthreads();
}

namespace pg8 {
#define PG8_LAS __attribute__((address_space(3)))
typedef unsigned short bf16_t;
typedef short bf16x8 __attribute__((ext_vector_type(8)));
typedef float f32x4 __attribute__((ext_vector_type(4)));
typedef unsigned u32x4 __attribute__((ext_vector_type(4)));
constexpr int BM = 256, BK = 64, HALF = 128, HTB = HALF * BK * 2  , STAGE_BYTES = 8 * HTB, NXCD = 8, WGM = 8;

__host__ __device__ __forceinline__ int lds_byte(int r, int c) { const int st = (r >> 4) * 2 + (c >> 5), rr = r & 15, cc = c & 31, ob = rr * 64 + cc * 2; return st * 1024 + (ob ^ (((ob >> 9) & 1) << 5)); }
__host__ __device__ __forceinline__ void stage_rc(int b, int& R, int& C) { const int st = b / 1024, sb = b % 1024, swz = sb ^ (((sb >> 9) & 1) << 5); R = (st >> 1) * 16 + swz / 64; C = (st & 1) * 32 + (swz % 64) / 2; }
__host__ __device__ __forceinline__ int perm32(int rho) { const int n = rho >> 4, i = rho & 15; return 8 * (i >> 2) + 4 * n + (i & 3); }

struct Unit { int pm, pn; };
struct Gemm { const bf16_t* A; const bf16_t* Bt; int M, N, K; };

struct StaticOrder {
    int nM, nN, nwg, G, c, wgm;
    __host__ __device__ void init(int M, int N, int G_, int c_, int wgm_ = WGM) { nM = M / BM; nN = N / BM; nwg = nM * nN; G = G_; c = c_; wgm = wgm_; }
    __host__ __device__ bool next(int i, Unit& u) const {
        const long L = (long)i * G + c; if (L >= nwg) return false;
        int wgid = (int)L; { const int q = nwg / NXCD, r = nwg % NXCD, xcd = wgid % NXCD, off = wgid / NXCD; wgid = (xcd < r ? xcd * (q + 1) : r * (q + 1) + (xcd - r) * q) + off; }
        const int nig = wgm * nN, gid = wgid / nig, fm = gid * wgm, gsz = (nM - fm) < wgm ? (nM - fm) : wgm;
        u.pm = fm + ((wgid % nig) % gsz); u.pn = (wgid % nig) / gsz; return true;
    }
    __device__ __forceinline__ void a_ready(const Unit&) const {}
    __device__ __forceinline__ void done(const Unit&) const {}
};


__device__ __forceinline__ void load_rs(float (&rs)[2][4], PG8_LAS unsigned char* lds, const Unit& u, int pm0, int wr, int fr) {
    const PG8_LAS float* RS = (const PG8_LAS float*)(lds + RS_OFF) + (u.pm != pm0 ? 256 : 0) + wr * 64 + fr;
#pragma unroll
    for (int ai = 0; ai < 2; ++ai)
#pragma unroll
        for (int m = 0; m < 4; ++m) rs[ai][m] = RS[ai * HALF + m * 16];
}
struct EpiGeluSS {
    static constexpr bool PERM = true, AFTER_DRAIN = false, APERM = false;
    bf16_t* O; float* vss; int pm0;
    __device__ __forceinline__ void operator()(f32x4 (&acc)[2][2][4][2], const Unit& u, int wr, int wc, int fr, int fq, PG8_LAS unsigned char* lds) const {
        const int row0 = u.pm * BM + wr * 64 + fr, col0 = u.pn * BM + wc * 32 + 8 * fq;
        const bool isv = u.pn >= 8;
        float rs[2][4]; load_rs(rs, lds, u, pm0, wr, fr);
#pragma unroll
        for (int ai = 0; ai < 2; ++ai)
#pragma unroll
            for (int m = 0; m < 4; ++m) { const int row = row0 + ai * HALF + m * 16; bf16_t* rowp = O + (size_t)row * 4096 + col0; float ss = 0.f;
#pragma unroll
                for (int bj = 0; bj < 2; ++bj) { const f32x4 v0 = gelu4(acc[ai][bj][m][0] * rs[ai][m]), v1 = gelu4(acc[ai][bj][m][1] * rs[ai][m]);
                    ss += (v0[0] * v0[0] + v0[1] * v0[1]) + (v0[2] * v0[2] + v0[3] * v0[3]) + (v1[0] * v1[0] + v1[1] * v1[1]) + (v1[2] * v1[2] + v1[3] * v1[3]);
                    u32x4 w; w.x = cvt_pk_bf16(v0[0], v0[1]); w.y = cvt_pk_bf16(v0[2], v0[3]); w.z = cvt_pk_bf16(v1[0], v1[1]); w.w = cvt_pk_bf16(v1[2], v1[3]);
                    *(u32x4*)(rowp + bj * HALF) = w; }
                if (isv) { ss += __shfl_xor(ss, 16); ss += __shfl_xor(ss, 32); if (fq == 0) vss[(size_t)row * 32 + (u.pn - 8) * 4 + wc] = ss; } }
    }
};
struct EpiPlainBf16 {
    static constexpr bool PERM = true, AFTER_DRAIN = false, APERM = false;
    bf16_t* O; int ldc; int pm0;
    __device__ __forceinline__ void operator()(f32x4 (&acc)[2][2][4][2], const Unit& u, int wr, int wc, int fr, int fq, PG8_LAS unsigned char* lds) const {
        const int row0 = u.pm * BM + wr * 64 + fr, col0 = u.pn * BM + wc * 32 + 8 * fq;
        float rs[2][4]; load_rs(rs, lds, u, pm0, wr, fr);
#pragma unroll
        for (int ai = 0; ai < 2; ++ai)
#pragma unroll
            for (int m = 0; m < 4; ++m) { bf16_t* rowp = O + (size_t)(row0 + ai * HALF + m * 16) * ldc + col0;
#pragma unroll
                for (int bj = 0; bj < 2; ++bj) { const f32x4 v0 = acc[ai][bj][m][0] * rs[ai][m], v1 = acc[ai][bj][m][1] * rs[ai][m];
                    u32x4 w; w.x = cvt_pk_bf16(v0[0], v0[1]); w.y = cvt_pk_bf16(v0[2], v0[3]); w.z = cvt_pk_bf16(v1[0], v1[1]); w.w = cvt_pk_bf16(v1[2], v1[3]);
                    *(u32x4*)(rowp + bj * HALF) = w; } }
    }
};
__device__ __forceinline__ f32x4 bf4lo(u32x4 r) { return (f32x4){bflo(r.x), bfhi(r.x), bflo(r.y), bfhi(r.y)}; }
__device__ __forceinline__ f32x4 bf4hi(u32x4 r) { return (f32x4){bflo(r.z), bfhi(r.z), bflo(r.w), bfhi(r.w)}; }
struct EpiRes {
    static constexpr bool PERM = true, AFTER_DRAIN = false, APERM = false;
    bf16_t* xn; float* hss; int pm0;
    __device__ __forceinline__ void operator()(f32x4 (&acc)[2][2][4][2], const Unit& u, int wr, int wc, int fr, int fq, PG8_LAS unsigned char*) const {
        const int row0 = u.pm * BM + wr * 64 + fr, col0 = u.pn * BM + wc * 32 + 8 * fq;
        u32x4 rb[8][2];
#define RES_LOAD(g) do { const size_t off_ = (size_t)(row0 + ((g) >> 2) * HALF + ((g) & 3) * 16) * DM + col0; rb[g][0] = *(const u32x4*)(xn + off_); rb[g][1] = *(const u32x4*)(xn + off_ + HALF); } while (0)
        RES_LOAD(0); RES_LOAD(1); RES_LOAD(2); RES_LOAD(3);
        asm volatile("" ::: "memory");
#pragma unroll
        for (int g = 0; g < 8; ++g) { const int ai = g >> 2, m = g & 3;
            if (g + 4 < 8) RES_LOAD((g + 4 < 8 ? g + 4 : 7));
            const int row = row0 + ai * HALF + m * 16; const size_t off = (size_t)row * DM + col0; float ss = 0.f;
#pragma unroll
            for (int bj = 0; bj < 2; ++bj) {
                const f32x4 o0 = bf4lo(rb[g][bj]) + acc[ai][bj][m][0], o1 = bf4hi(rb[g][bj]) + acc[ai][bj][m][1];
                ss += (o0[0] * o0[0] + o0[1] * o0[1]) + (o0[2] * o0[2] + o0[3] * o0[3]) + (o1[0] * o1[0] + o1[1] * o1[1]) + (o1[2] * o1[2] + o1[3] * o1[3]);
                u32x4 w; w.x = cvt_pk_bf16(o0[0], o0[1]); w.y = cvt_pk_bf16(o0[2], o0[3]); w.z = cvt_pk_bf16(o1[0], o1[1]); w.w = cvt_pk_bf16(o1[2], o1[3]);
                *(u32x4*)(xn + off + bj * HALF) = w; }
            ss += __shfl_xor(ss, 16); ss += __shfl_xor(ss, 32); if (fq == 0) hss[(size_t)row * 64 + u.pn * 4 + wc] = ss;
            asm volatile("" ::: "memory"); }
#undef RES_LOAD
    }
};
struct EpiGlu {
    static constexpr bool PERM = true, AFTER_DRAIN = false, APERM = false;
    bf16_t* xn; float* hss; int pm0;
    __device__ __forceinline__ void operator()(f32x4 (&acc)[2][2][4][2], const Unit& u, int wr, int wc, int fr, int fq, PG8_LAS unsigned char*) const {
        const int row0 = u.pm * BM + wr * 64 + fr, col0 = u.pn * HALF + wc * 32 + 8 * fq;
        u32x4 rb[8];
#define RES_LOAD(g) do { const size_t off_ = (size_t)(row0 + ((g) >> 2) * HALF + ((g) & 3) * 16) * DM + col0; rb[g] = *(const u32x4*)(xn + off_); } while (0)
        RES_LOAD(0); RES_LOAD(1); RES_LOAD(2); RES_LOAD(3);
        asm volatile("" ::: "memory");
#pragma unroll
        for (int g = 0; g < 8; ++g) { const int ai = g >> 2, m = g & 3;
            if (g + 4 < 8) RES_LOAD((g + 4 < 8 ? g + 4 : 7));
            const int row = row0 + ai * HALF + m * 16; const size_t off = (size_t)row * DM + col0; float ss = 0.f;
            f32x4 o[2]; o[0] = bf4lo(rb[g]); o[1] = bf4hi(rb[g]);
#pragma unroll
            for (int n = 0; n < 2; ++n) { const f32x4 ga = acc[ai][0][m][n], gb = acc[ai][1][m][n];
#pragma unroll
                for (int j = 0; j < 4; ++j) o[n][j] += ga[j] * sigmoid_f(gb[j]);
                ss += (o[n][0] * o[n][0] + o[n][1] * o[n][1]) + (o[n][2] * o[n][2] + o[n][3] * o[n][3]); }
            u32x4 w; w.x = cvt_pk_bf16(o[0][0], o[0][1]); w.y = cvt_pk_bf16(o[0][2], o[0][3]); w.z = cvt_pk_bf16(o[1][0], o[1][1]); w.w = cvt_pk_bf16(o[1][2], o[1][3]);
            *(u32x4*)(xn + off) = w;
            ss += __shfl_xor(ss, 16); ss += __shfl_xor(ss, 32); if (fq == 0) hss[(size_t)row * 64 + u.pn * 4 + wc] = ss;
            asm volatile("" ::: "memory"); }
#undef RES_LOAD
    }
};
struct EpiUp {
    static constexpr bool PERM = true, AFTER_DRAIN = false, APERM = true;
    bf16_t* HID; float* ZH; const float* cw; const float* cb; int pm0;
    __device__ __forceinline__ void operator()(f32x4 (&acc)[2][2][4][2], const Unit& u, int wr, int wc, int fr, int fq, PG8_LAS unsigned char* lds) const {
        PG8_LAS float* halo = (PG8_LAS float*)(lds + HALO_OFF);
        const int tcol = wc * 32 + 8 * fq;
        const int tl0 = 8 * (16 * wr + fr);
        { const PG8_LAS float* RS = (const PG8_LAS float*)(lds + RS_OFF) + (u.pm != pm0 ? 256 : 0) + tl0;
          const f32x4 ra = *(const PG8_LAS f32x4*)RS, rb = *(const PG8_LAS f32x4*)(RS + 4);
#pragma unroll
          for (int bj = 0; bj < 2; ++bj)
#pragma unroll
            for (int n = 0; n < 2; ++n) {
#pragma unroll
              for (int m = 0; m < 4; ++m) { acc[0][bj][m][n] = acc[0][bj][m][n] * ra[m]; acc[1][bj][m][n] = acc[1][bj][m][n] * rb[m]; } } }
        if (wr == 0 && fr == 15) {
#pragma unroll
            for (int bj = 0; bj < 2; ++bj)
#pragma unroll
                for (int n = 0; n < 2; ++n) { *(PG8_LAS f32x4*)(halo + bj * HALF + tcol + 4 * n) = acc[1][bj][2][n]; *(PG8_LAS f32x4*)(halo + 256 + bj * HALF + tcol + 4 * n) = acc[1][bj][3][n]; }
        }
        if (wr == 0 && fr == 0) {
#pragma unroll
            for (int bj = 0; bj < 2; ++bj)
#pragma unroll
                for (int n = 0; n < 2; ++n) { float* z = ZH + (size_t)(u.pm * 4) * FF2 + bj * FF + u.pn * HALF + tcol + 4 * n; *(f32x4*)z = acc[0][bj][0][n]; *(f32x4*)(z + FF2) = acc[0][bj][1][n]; }
        }
        if (wr == 1 && fr == 15) {
#pragma unroll
            for (int bj = 0; bj < 2; ++bj)
#pragma unroll
                for (int n = 0; n < 2; ++n) { float* z = ZH + (size_t)(u.pm * 4 + 2) * FF2 + bj * FF + u.pn * HALF + tcol + 4 * n; *(f32x4*)z = acc[1][bj][2][n]; *(f32x4*)(z + FF2) = acc[1][bj][3][n]; }
        }
        LDS_BARRIER();
#pragma unroll
        for (int n = 0; n < 2; ++n)
#pragma unroll
            for (int bj = 0; bj < 2; ++bj) {
                const int c = bj * FF + u.pn * HALF + tcol + 4 * n;
                const f32x4 w0 = *(const f32x4*)(cw + c), w1 = *(const f32x4*)(cw + FF2 + c), w2 = *(const f32x4*)(cw + 2 * FF2 + c), bb = *(const f32x4*)(cb + c);
                f32x4 h6 = (f32x4){0.f, 0.f, 0.f, 0.f}, h7 = h6;
                if (wr == 1) { h6 = *(const PG8_LAS f32x4*)(halo + bj * HALF + tcol + 4 * n); h7 = *(const PG8_LAS f32x4*)(halo + 256 + bj * HALF + tcol + 4 * n); }
                f32x4 s6, s7;
#pragma unroll
                for (int j = 0; j < 4; ++j) { s6[j] = dpp_shr1_old(h6[j], acc[1][bj][2][n][j]); s7[j] = dpp_shr1_old(h7[j], acc[1][bj][3][n][j]); }
#pragma unroll
                for (int r8 = 7; r8 >= 0; --r8) {
                    const f32x4 zc = acc[r8 >> 2][bj][r8 & 3][n];
                    const f32x4 z1 = (r8 >= 1) ? acc[(r8 >= 1 ? r8 - 1 : 0) >> 2][bj][(r8 >= 1 ? r8 - 1 : 0) & 3][n] : s7;
                    const f32x4 z2 = (r8 >= 2) ? acc[(r8 >= 2 ? r8 - 2 : 0) >> 2][bj][(r8 >= 2 ? r8 - 2 : 0) & 3][n] : (r8 == 1 ? s7 : s6);
                    f32x4 r;
#pragma unroll
                    for (int j = 0; j < 4; ++j) r[j] = __builtin_fmaf(w0[j], z2[j], __builtin_fmaf(w1[j], z1[j], __builtin_fmaf(w2[j], zc[j], bb[j])));
                    acc[r8 >> 2][bj][r8 & 3][n] = r;
                    asm volatile("" : "+v"(acc[r8 >> 2][bj][r8 & 3][n]));
                }
                asm volatile("" ::: "memory");
            }
#pragma unroll
        for (int ai = 0; ai < 2; ++ai)
#pragma unroll
            for (int m = 0; m < 4; ++m) {
                bf16_t* rowp = HID + (size_t)(u.pm * BM + tl0 + 4 * ai + m) * FF + u.pn * HALF + tcol;
                float o[8];
#pragma unroll
                for (int n = 0; n < 2; ++n)
#pragma unroll
                    for (int j = 0; j < 4; ++j) { const float g = acc[ai][0][m][n][j], v = acc[ai][1][m][n][j]; o[4 * n + j] = g * sigmoid_f(g) * v; }
                u32x4 w; w.x = cvt_pk_bf16(o[0], o[1]); w.y = cvt_pk_bf16(o[2], o[3]); w.z = cvt_pk_bf16(o[4], o[5]); w.w = cvt_pk_bf16(o[6], o[7]);
                *(u32x4*)rowp = w;
            }
    }
};
template <class Epi, class Sched, bool ALIGN_EPI = false, bool SP2 = false>
__device__ __forceinline__ void gemm_phase(PG8_LAS unsigned char* lds, const Gemm g, const Sched& S, const Epi& E, const int tid_in) {
    const int tid = tid_in, wid = __builtin_amdgcn_readfirstlane(tid >> 6), lane = tid & 63, wr = wid >> 2, wc = wid & 3, fr = lane & 15, fq = lane >> 4;
    const int K = g.K, nt = K / BK;
    unsigned voffA[2], voffB[2];
#pragma unroll
    for (int i = 0; i < 2; ++i) { int R, C; stage_rc(tid * 16 + i * 8192, R, C); const int Rb = Epi::PERM ? ((R & ~31) + perm32(R & 31)) : R;
        const int Ra = Epi::APERM ? (8 * (16 * ((R >> 6) & 1) + (R & 15)) + ((R >> 4) & 3)) : R; voffA[i] = (unsigned)(Ra * K + C) * 2u; voffB[i] = (unsigned)(Rb * K + C) * 2u; }
    const size_t kstep = (size_t)(BK * 2);
    const size_t hstep = (size_t)HALF * K * 2;
    const size_t tstep = 2 * hstep;
    const size_t hstepA = Epi::APERM ? (size_t)4 * K * 2 : hstep;
    const unsigned ldsw = (unsigned)wid * 1024u;
    const int aoff = lds_byte(wr * 64 + fr, fq * 8), boff = lds_byte(wc * 32 + fr, fq * 8);
#define PG8_SA(b, h) (((b) * 2 + (h)) * HTB)
#define PG8_SB(b, h) ((4 + (b) * 2 + (h)) * HTB)
#define PG8_STAGE(bufoff, gbase, voff) do { _Pragma("unroll") for (int _i = 0; _i < 2; ++_i) \
        __builtin_amdgcn_global_load_lds((const unsigned*)((const char*)(gbase) + (voff)[_i]), (PG8_LAS unsigned*)(lds + (bufoff) + ldsw + _i * 8192), 16, 0, 0); } while (0)
#define PG8_LDA(dst, b, h) do { _Pragma("unroll") for (int m = 0; m < 4; ++m) _Pragma("unroll") for (int k = 0; k < 2; ++k) dst[m][k] = *(const PG8_LAS bf16x8*)(lds + PG8_SA(b, h) + aoff + m * 2048 + k * 1024); } while (0)
#define PG8_LDB(dst, b, h) do { _Pragma("unroll") for (int n = 0; n < 2; ++n) _Pragma("unroll") for (int k = 0; k < 2; ++k) dst[n][k] = *(const PG8_LAS bf16x8*)(lds + PG8_SB(b, h) + boff + n * 2048 + k * 1024); } while (0)
#define PG8_MMA(ai, bj, At, Bt) do { __builtin_amdgcn_s_setprio(3); _Pragma("unroll") for (int m = 0; m < 4; ++m) _Pragma("unroll") for (int n = 0; n < 2; ++n) _Pragma("unroll") for (int k = 0; k < 2; ++k) \
        acc[ai][bj][m][n] = __builtin_amdgcn_mfma_f32_16x16x32_bf16(Bt[n][k], At[m][k], acc[ai][bj][m][n], 0, 0, 0); __builtin_amdgcn_s_setprio(0); } while (0)
#define PG8_WAIT_V(n) asm volatile("s_waitcnt vmcnt(" #n ")" ::: "memory")
#define PG8_WAIT_L(n) asm volatile("s_waitcnt lgkmcnt(" #n ")" ::: "memory")
#define PG8_BAR __builtin_amdgcn_s_barrier()
#define PG8_SCHED __builtin_amdgcn_sched_barrier(0)
    Unit cur, nxt; int ui = 0;
    if (!S.next(0, cur)) return;
    f32x4 acc[2][2][4][2];
#pragma unroll
    for (int a = 0; a < 2; ++a)
#pragma unroll
        for (int b = 0; b < 2; ++b)
#pragma unroll
            for (int m = 0; m < 4; ++m)
#pragma unroll
                for (int n = 0; n < 2; ++n) acc[a][b][m][n] = (f32x4){0.f, 0.f, 0.f, 0.f};
    bf16x8 At[4][2], B0[2][2], B1[2][2];
    const char* cA = (const char*)g.A + (size_t)cur.pm * tstep; const char* cB = (const char*)g.Bt + (size_t)cur.pn * tstep;
    S.a_ready(cur);
    if constexpr (SP2) {
        PG8_STAGE(PG8_SB(0, 0), cB, voffB); PG8_STAGE(PG8_SB(0, 1), cB + hstep, voffB); PG8_STAGE(PG8_SA(0, 0), cA, voffA); PG8_STAGE(PG8_SA(0, 1), cA + hstepA, voffA);
        if (wr == 1) PG8_BAR;
        PG8_WAIT_V(2); PG8_BAR;
        PG8_STAGE(PG8_SB(1, 0), cB + kstep, voffB); PG8_STAGE(PG8_SA(1, 0), cA + kstep, voffA); PG8_STAGE(PG8_SB(1, 1), cB + hstep + kstep, voffB);
        PG8_WAIT_V(6); PG8_BAR;
    } else {
        PG8_STAGE(PG8_SB(0, 0), cB, voffB); PG8_STAGE(PG8_SA(0, 0), cA, voffA); PG8_STAGE(PG8_SB(0, 1), cB + hstep, voffB); PG8_STAGE(PG8_SA(0, 1), cA + hstepA, voffA);
        if (wr == 1) PG8_BAR;
        PG8_WAIT_V(4); PG8_BAR;
        PG8_STAGE(PG8_SB(1, 0), cB + kstep, voffB); PG8_STAGE(PG8_SA(1, 0), cA + kstep, voffA); PG8_STAGE(PG8_SB(1, 1), cB + hstep + kstep, voffB);
        PG8_WAIT_V(6); PG8_BAR;
    }
    for (;;) {
        const bool has_next = S.next(ui + 1, nxt);
        const char* nA = has_next ? (const char*)g.A + (size_t)nxt.pm * tstep : cA; const char* nB = has_next ? (const char*)g.Bt + (size_t)nxt.pn * tstep : cB;
        for (int t = 0; t < nt; t += 2) {
            const bool last = (t == nt - 2);
            const char* a1 = cA + (size_t)(t + 1) * kstep;
            const char* a2 = last ? nA : cA + (size_t)(t + 2) * kstep; const char* b2 = last ? nB : cB + (size_t)(t + 2) * kstep;
            const char* a3 = a2 + kstep; const char* b3 = b2 + kstep;
            if (last && has_next) S.a_ready(nxt);
            if constexpr (SP2) {
            PG8_LDB(B0, 0, 0); PG8_LDB(B1, 0, 1); PG8_SCHED; PG8_LDA(At, 0, 0); PG8_STAGE(PG8_SA(1, 1), a1 + hstepA, voffA);
            PG8_WAIT_V(8); PG8_WAIT_L(0); PG8_BAR; PG8_MMA(0, 0, At, B0); PG8_MMA(0, 1, At, B1); PG8_BAR; PG8_SCHED;
            PG8_LDA(At, 0, 1); PG8_STAGE(PG8_SB(0, 0), b2, voffB); PG8_STAGE(PG8_SB(0, 1), b2 + hstep, voffB); PG8_STAGE(PG8_SA(0, 0), a2, voffA);
            PG8_WAIT_V(8); PG8_WAIT_L(0); PG8_BAR; PG8_MMA(1, 0, At, B0); PG8_MMA(1, 1, At, B1); PG8_BAR; PG8_SCHED;
            PG8_LDB(B0, 1, 0); PG8_LDB(B1, 1, 1); PG8_SCHED; PG8_LDA(At, 1, 0); PG8_STAGE(PG8_SA(0, 1), a2 + hstepA, voffA);
            PG8_WAIT_V(8); PG8_WAIT_L(0); PG8_BAR; PG8_MMA(0, 0, At, B0); PG8_MMA(0, 1, At, B1); PG8_BAR; PG8_SCHED;
            PG8_LDA(At, 1, 1); PG8_STAGE(PG8_SB(1, 0), b3, voffB); PG8_STAGE(PG8_SB(1, 1), b3 + hstep, voffB); PG8_STAGE(PG8_SA(1, 0), a3, voffA);
            PG8_WAIT_V(8); PG8_WAIT_L(0); PG8_BAR; PG8_MMA(1, 0, At, B0); PG8_MMA(1, 1, At, B1); PG8_BAR; PG8_SCHED;
            } else {
            PG8_LDB(B0, 0, 0); PG8_SCHED; PG8_LDA(At, 0, 0); PG8_STAGE(PG8_SA(1, 1), a1 + hstepA, voffA);
            PG8_WAIT_L(8); PG8_BAR; PG8_WAIT_L(0); PG8_MMA(0, 0, At, B0); PG8_BAR; PG8_SCHED;
            PG8_LDB(B1, 0, 1); PG8_STAGE(PG8_SB(0, 0), b2, voffB);
            PG8_BAR; PG8_WAIT_L(0); PG8_MMA(0, 1, At, B1); PG8_BAR;
            PG8_LDA(At, 0, 1); PG8_STAGE(PG8_SA(0, 0), a2, voffA);
            PG8_BAR; PG8_WAIT_L(0); PG8_MMA(1, 0, At, B0); PG8_BAR; PG8_SCHED;
            PG8_STAGE(PG8_SB(0, 1), b2 + hstep, voffB);
            PG8_WAIT_V(6); PG8_BAR; PG8_MMA(1, 1, At, B1); PG8_BAR;
            PG8_LDB(B0, 1, 0); PG8_SCHED; PG8_LDA(At, 1, 0); PG8_STAGE(PG8_SA(0, 1), a2 + hstepA, voffA);
            PG8_WAIT_L(8); PG8_BAR; PG8_WAIT_L(0); PG8_MMA(0, 0, At, B0); PG8_BAR; PG8_SCHED;
            PG8_LDB(B1, 1, 1); PG8_STAGE(PG8_SB(1, 0), b3, voffB);
            PG8_BAR; PG8_WAIT_L(0); PG8_MMA(0, 1, At, B1); PG8_BAR;
            PG8_LDA(At, 1, 1); PG8_STAGE(PG8_SA(1, 0), a3, voffA);
            PG8_BAR; PG8_WAIT_L(0); PG8_MMA(1, 0, At, B0); PG8_BAR; PG8_SCHED;
            PG8_STAGE(PG8_SB(1, 1), b3 + hstep, voffB);
            PG8_WAIT_V(6); PG8_BAR; PG8_MMA(1, 1, At, B1); PG8_BAR;
            }
        }
        if constexpr (ALIGN_EPI) { if (wr == 0) PG8_BAR; }
        if constexpr (!Epi::AFTER_DRAIN) { E(acc, cur, wr, wc, fr, fq, lds); S.done(cur); }
        if (!has_next) break;
#pragma unroll
        for (int a = 0; a < 2; ++a)
#pragma unroll
            for (int b = 0; b < 2; ++b)
#pragma unroll
                for (int m = 0; m < 4; ++m)
#pragma unroll
                    for (int n = 0; n < 2; ++n) acc[a][b][m][n] = (f32x4){0.f, 0.f, 0.f, 0.f};
        cur = nxt; cA = nA; cB = nB; ++ui;
        if constexpr (ALIGN_EPI) { if (wr == 1) PG8_BAR; }
    }
    PG8_WAIT_V(0);
    if constexpr (!ALIGN_EPI) { if (wr == 0) PG8_BAR; }
    PG8_BAR;
    if constexpr (Epi::AFTER_DRAIN) { E.fused(acc, cur, wr, wc, fr, fq, lds, wid, lane); S.done(cur); }
#undef PG8_SA
#undef PG8_SB
#undef PG8_STAGE
#undef PG8_LDA
#undef PG8_LDB
#undef PG8_MMA
#undef PG8_WAIT_V
#undef PG8_WAIT_L
#undef PG8_BAR
#undef PG8_SCHED
}
}

struct Ctx { LAS unsigned char* lds; int tid, lane, wave, wg, G; };

__device__ __forceinline__ void transpose_load(float (&tv)[32], const float* W, int N, int item, int lane) {
    const int nblk = N / 32, kb = item / nblk, nb = item % nblk, k0 = 64 * kb, n0 = 32 * nb;
    const float* src = W + (size_t)(k0 + (lane >> 5)) * N + n0 + (lane & 31);
#pragma unroll
    for (int i = 0; i < 32; ++i) tv[i] = src[(size_t)(2 * i) * N];
}
__device__ __forceinline__ void transpose_store(const float (&tv)[32], int K, int N, bf16_t* WT, const float* kscale, int half, LAS float* scr, int item, int lane) {
    const int nblk = N / 32, kb = item / nblk, nb = item % nblk, k0 = 64 * kb, n0 = 32 * nb;
#pragma unroll
    for (int i = 0; i < 32; ++i) { const int kk = 2 * i + (lane >> 5); float v = tv[i]; if (kscale) v *= kscale[k0 + kk]; scr[kk * 33 + (lane & 31)] = v; }
    asm volatile("s_waitcnt lgkmcnt(0)" ::: "memory");
    const int c = lane & 7;
    const int d0 = half ? ((n0 % half) / 128) * 256 + (n0 / half) * 128 + (n0 % 128) : n0;
#pragma unroll
    for (int j = 0; j < 4; ++j) { const int n = (lane >> 3) + 8 * j; const LAS float* s = scr + (8 * c) * 33 + n;
        u32x4 o; o.x = cvt_pk_bf16(s[0 * 33], s[1 * 33]); o.y = cvt_pk_bf16(s[2 * 33], s[3 * 33]); o.z = cvt_pk_bf16(s[4 * 33], s[5 * 33]); o.w = cvt_pk_bf16(s[6 * 33], s[7 * 33]);
        *(u32x4*)(WT + (size_t)(d0 + n) * K + k0 + 8 * c) = o; }
    asm volatile("s_waitcnt lgkmcnt(0)" ::: "memory");
}
__device__ __forceinline__ void prep_mat(const Ctx& C, const float* W, int K, int N, bf16_t* WT, const float* kscale, int half) {
    LAS float* scr = (LAS float*)(C.lds + C.wave * 16384);
    const int gw = C.wg * NWAVES + C.wave, NGW = C.G * NWAVES, items = (K / 64) * (N / 32);
    float ta[32], tb[32];
    int it = gw;
    if (it < items) transpose_load(ta, W, N, it, C.lane);
    while (it < items) {
        const int nit = it + NGW;
        if (nit < items) transpose_load(tb, W, N, nit, C.lane);
        transpose_store(ta, K, N, WT, kscale, half, scr, it, C.lane);
#pragma unroll
        for (int i = 0; i < 32; ++i) ta[i] = tb[i];
        it = nit;
    }
}

__device__ __forceinline__ void x_in_phase(const Ctx& C, const float* src, bf16_t* xn, float* hss) {
    const int gw = C.wg * NWAVES + C.wave, NGW = C.G * NWAVES;
    for (int m = gw; m < M_TOK; m += NGW) {
        const f32x4* xr = (const f32x4*)(src + (size_t)m * DM) + C.lane;
        f32x4 v[8]; float ss = 0.f;
#pragma unroll
        for (int j = 0; j < 8; ++j) { v[j] = xr[64 * j]; ss += (v[j][0] * v[j][0] + v[j][1] * v[j][1]) + (v[j][2] * v[j][2] + v[j][3] * v[j][3]); }
        ss = wave_sum(ss);
        u32x2* o = (u32x2*)(xn + (size_t)m * DM) + C.lane;
#pragma unroll
        for (int j = 0; j < 8; ++j) { u32x2 w; w.x = cvt_pk_bf16(v[j][0], v[j][1]); w.y = cvt_pk_bf16(v[j][2], v[j][3]); o[64 * j] = w; }
        if (C.lane < 32) hss[(size_t)m * 64 + C.lane] = C.lane == 0 ? ss : 0.f;
    }
}
__device__ __forceinline__ void final_norm_phase(const Ctx& C, const bf16_t* xn, const float* hss, const float* gfin, float* outf) {
    const int gw = C.wg * NWAVES + C.wave, NGW = C.G * NWAVES;
    for (int m = gw; m < M_TOK; m += NGW) {
        float s = C.lane < 32 ? hss[(size_t)m * 64 + C.lane] : 0.f;
        const float rs = 1.0f / sqrtf(wave_sum(s) * (1.0f / DM) + EPS);
        const u32x4* xr = (const u32x4*)(xn + (size_t)m * DM) + C.lane;
        f32x4* o = (f32x4*)(outf + (size_t)m * DM); const f32x4* g4 = (const f32x4*)gfin;
#pragma unroll
        for (int j = 0; j < 4; ++j) { const u32x4 r = xr[64 * j]; const int c4 = 2 * (C.lane + 64 * j);
            o[c4] = pg8::bf4lo(r) * rs * g4[c4]; o[c4 + 1] = pg8::bf4hi(r) * rs * g4[c4 + 1]; }
    }
}

__device__ __forceinline__ void s5_prep(const Ctx& C, const float* a_re, const float* a_im, const float* log_dt, const float* b_re, const float* b_im, const float* c_re, const float* c_im,
                                        float* ABAR, bf16_t* BB, bf16_t* CM) {
    const int gt = C.wg * (NWAVES * 64) + C.tid, NT = C.G * NWAVES * 64;
    for (int idx = gt; idx < 128 * 64; idx += NT) {
        const int g = idx >> 6, p = idx & 63;
        const double dt = (double)expf(log_dt[g]);
        const double lr = (double)a_re[idx], li = (double)a_im[idx];
        const double xr = dt * lr; double e = 1.0, term = 1.0;
        for (int k = 1; k <= 14; ++k) { term *= xr / k; e += term; }
        const double x = dt * li; const double kq = rint(x * 0.63661977236758134308); const double r = (x - kq * 1.57079632679489655800) - kq * 6.123233995736766e-17;
        const double r2 = r * r; double sn = r, cs = 1.0, ts = r, tc = 1.0;
        for (int k = 1; k <= 10; ++k) { tc *= -r2 / ((2 * k - 1) * (2 * k)); cs += tc; ts *= -r2 / ((2 * k) * (2 * k + 1)); sn += ts; }
        const int qd = ((int)kq) & 3; double c_ = cs, s_ = sn;
        if (qd == 1) { c_ = -sn; s_ = cs; } else if (qd == 2) { c_ = -cs; s_ = -sn; } else if (qd == 3) { c_ = sn; s_ = -cs; }
        const double abr = e * c_, abi = e * s_;
        ABAR[idx * 2] = (float)abr; ABAR[idx * 2 + 1] = (float)abi;
        const double den = lr * lr + li * li;
        const double qr = ((abr - 1.0) * lr + abi * li) / den, qi = (abi * lr - (abr - 1.0) * li) / den;
        for (int c = 0; c < 16; ++c) {
            const double br = (double)b_re[(size_t)idx * 16 + c], bi = (double)b_im[(size_t)idx * 16 + c];
            const float bbr = (float)(qr * br - qi * bi), bbi = (float)(qr * bi + qi * br);
            BB[((size_t)g * 128 + p) * 16 + c] = (bf16_t)(cvt_pk_bf16(bbr, 0.f) & 0xffffu);
            BB[((size_t)g * 128 + 64 + p) * 16 + c] = (bf16_t)(cvt_pk_bf16(bbi, 0.f) & 0xffffu);
            const float cr = c_re[((size_t)g * 16 + c) * 64 + p], ci = c_im[((size_t)g * 16 + c) * 64 + p];
            *(unsigned*)(CM + ((size_t)g * 16 + c) * 128 + 2 * p) = cvt_pk_bf16(cr, -ci);
        }
    }
}

__device__ __forceinline__ void ws_prep(const Ctx& C, const float* ws, bf16_t* WSB) {
    const int gt = C.wg * (NWAVES * 64) + C.tid, NT = C.G * NWAVES * 64;
    for (int i = gt; i < 16 * 128 * 128 / 2; i += NT) { const int e = 2 * i, t = (e >> 7) & 127, s = e & 127; const f32x2 w = *(const f32x2*)(ws + e);
        *(unsigned*)(WSB + e) = cvt_pk_bf16(s <= t ? w.x : 0.f, s + 1 <= t ? w.y : 0.f); }
}

__device__ __forceinline__ unsigned off_b(unsigned row, unsigned ch) { return 256u * row + 16u * (ch ^ (((row & 3) << 2) | ((row >> 2) & 3))); }
__device__ __forceinline__ unsigned tr_read_addr_16(unsigned lane, unsigned c, unsigned ks, unsigned t) {
    const unsigned g = lane >> 4, q = (lane & 15) >> 2, p = lane & 3;
    return off_b(32 * ks + 8 * g + 4 * t + q, 2 * c + (p >> 1)) + 8 * (p & 1);
}
__device__ __forceinline__ void tr_read8(bf16x8 (&v)[4], const unsigned (&a)[8]) {
    u32x2 r0, r1, r2, r3, r4, r5, r6, r7;
    asm volatile("ds_read_b64_tr_b16 %0, %8\n\tds_read_b64_tr_b16 %1, %9\n\tds_read_b64_tr_b16 %2, %10\n\tds_read_b64_tr_b16 %3, %11\n\t"
                 "ds_read_b64_tr_b16 %4, %12\n\tds_read_b64_tr_b16 %5, %13\n\tds_read_b64_tr_b16 %6, %14\n\tds_read_b64_tr_b16 %7, %15\n\ts_waitcnt lgkmcnt(0)"
                 : "=&v"(r0), "=&v"(r1), "=&v"(r2), "=&v"(r3), "=&v"(r4), "=&v"(r5), "=&v"(r6), "=&v"(r7)
                 : "v"(a[0]), "v"(a[1]), "v"(a[2]), "v"(a[3]), "v"(a[4]), "v"(a[5]), "v"(a[6]), "v"(a[7]) : "memory");
    v[0] = __builtin_bit_cast(bf16x8, (u32x4){r0.x, r0.y, r1.x, r1.y}); v[1] = __builtin_bit_cast(bf16x8, (u32x4){r2.x, r2.y, r3.x, r3.y});
    v[2] = __builtin_bit_cast(bf16x8, (u32x4){r4.x, r4.y, r5.x, r5.y}); v[3] = __builtin_bit_cast(bf16x8, (u32x4){r6.x, r6.y, r7.x, r7.y});
}
__device__ __forceinline__ void sgu_phase(const Ctx& C, const bf16_t* Z1, const float* VSS, const float* gv, const bf16_t* WSB, const float* bs, bf16_t* Gout) {
    LAS unsigned char* Vs = C.lds;
    LAS float* rsv = (LAS float*)(C.lds + 32768);
    const int lane = C.lane, w = C.wave, fr = lane & 15, g4 = lane >> 4;
    const unsigned ldsbase = (unsigned)(uintptr_t)Vs;
    const int tb = w >> 1, dh = w & 1;
    const int ch = C.tid & 15, srow = C.tid >> 4;
    for (int task = C.wg; task < M_TOK / CHK; task += C.G) {
        const int tok0 = task * CHK;
        __syncthreads();
        if (C.tid < 128) { const f32x4* p = (const f32x4*)(VSS + (size_t)(tok0 + C.tid) * 32); float s = 0.f;
#pragma unroll
            for (int i = 0; i < 8; ++i) { const f32x4 q = p[i]; s += (q[0] + q[1]) + (q[2] + q[3]); }
            rsv[C.tid] = 1.0f / sqrtf(s * (1.0f / DM) + EPS); }
        u32x4 vraw[4];
#pragma unroll
        for (int ps = 0; ps < 4; ++ps) vraw[ps] = *(const u32x4*)(Z1 + (size_t)(tok0 + ps * 32 + srow) * 4096 + 2048 + 8 * ch);
        __syncthreads();
        for (int h = 0; h < 16; ++h) {
            {
                const f32x4 ga = *(const f32x4*)(gv + 128 * h + 8 * ch), gb = *(const f32x4*)(gv + 128 * h + 8 * ch + 4);
#pragma unroll
                for (int ps = 0; ps < 4; ++ps) { const int s = ps * 32 + srow; const u32x4 raw = vraw[ps]; const float r = rsv[s];
                    u32x4 o; o.x = cvt_pk_bf16(bflo(raw.x) * r * ga[0], bfhi(raw.x) * r * ga[1]); o.y = cvt_pk_bf16(bflo(raw.y) * r * ga[2], bfhi(raw.y) * r * ga[3]);
                    o.z = cvt_pk_bf16(bflo(raw.z) * r * gb[0], bfhi(raw.z) * r * gb[1]); o.w = cvt_pk_bf16(bflo(raw.w) * r * gb[2], bfhi(raw.w) * r * gb[3]);
                    *(LAS u32x4*)(Vs + off_b(s, ch)) = o; }
            }
            if (h + 1 < 16) {
#pragma unroll
                for (int ps = 0; ps < 4; ++ps) vraw[ps] = *(const u32x4*)(Z1 + (size_t)(tok0 + ps * 32 + srow) * 4096 + 2048 + 128 * (h + 1) + 8 * ch);
            }
            bf16x8 wf[4][2];
#pragma unroll
            for (int kk = 0; kk < 4; ++kk)
#pragma unroll
                for (int mt = 0; mt < 2; ++mt) wf[kk][mt] = *(const bf16x8*)(WSB + ((size_t)h * 128 + 32 * tb + 16 * mt + fr) * 128 + 32 * (kk <= tb ? kk : tb) + 8 * g4);
            u32x2 uu[2][4];
#pragma unroll
            for (int mt = 0; mt < 2; ++mt)
#pragma unroll
                for (int nt = 0; nt < 4; ++nt) uu[mt][nt] = *(const u32x2*)(Z1 + (size_t)(tok0 + 32 * tb + 16 * mt + fr) * 4096 + 128 * h + 64 * dh + 16 * nt + 4 * g4);
            __syncthreads();
            f32x4 acc[2][4];
#pragma unroll
            for (int a = 0; a < 2; ++a)
#pragma unroll
                for (int b = 0; b < 4; ++b) acc[a][b] = (f32x4){0.f, 0.f, 0.f, 0.f};
#pragma unroll
            for (int kk = 0; kk < 4; ++kk) {
                if (kk <= tb) {
                    unsigned ad[8]; bf16x8 vf[4];
#pragma unroll
                    for (int nt = 0; nt < 4; ++nt) { ad[2 * nt] = ldsbase + tr_read_addr_16(lane, 4 * dh + nt, kk, 0); ad[2 * nt + 1] = ldsbase + tr_read_addr_16(lane, 4 * dh + nt, kk, 1); }
                    tr_read8(vf, ad);
#pragma unroll
                    for (int nt = 0; nt < 4; ++nt)
#pragma unroll
                        for (int mt = 0; mt < 2; ++mt) acc[mt][nt] = __builtin_amdgcn_mfma_f32_16x16x32_bf16(vf[nt], wf[kk][mt], acc[mt][nt], 0, 0, 0);
                }
            }
#pragma unroll
            for (int mt = 0; mt < 2; ++mt) { const int t = 32 * tb + 16 * mt + fr; const float bias = bs[h * 128 + t];
#pragma unroll
                for (int nt = 0; nt < 4; ++nt) { const int d = 128 * h + 64 * dh + 16 * nt + 4 * g4; const u32x2 u2 = uu[mt][nt];
                    u32x2 o; o.x = cvt_pk_bf16(bflo(u2.x) * (acc[mt][nt][0] + bias), bfhi(u2.x) * (acc[mt][nt][1] + bias)); o.y = cvt_pk_bf16(bflo(u2.y) * (acc[mt][nt][2] + bias), bfhi(u2.y) * (acc[mt][nt][3] + bias));
                    *(u32x2*)(Gout + (size_t)(tok0 + t) * DM + d) = o; } }
            __syncthreads();
        }
    }
}

constexpr int S5_SUB = 16, S5_NS = SEQ / S5_SUB, S5_HP = 272;
__device__ __forceinline__ void s5_phase(const Ctx& C, const bf16_t* U, bf16_t* Gout, const float* ABAR, const bf16_t* BB, const bf16_t* CM, const float* Dsk) {
    const int lane = C.lane, fr = lane & 15, g4 = lane >> 4, pw = C.wave & 3, role = C.wave >> 2;
    for (int task = C.wg; task < NBATCH * 32; task += C.G) {
        const int b = task >> 5, g = (task & 31) * 4 + pw;
        const size_t tokb = (size_t)b * SEQ;
        LAS unsigned char* bub = C.lds + pw * 16384;
        LAS unsigned char* hb = C.lds + 65536 + pw * (2 * S5_SUB * S5_HP);
        __syncthreads();
        if (role == 1) {
            bf16x8 bfr[8], cfr[4], dfr; const bf16x8 zero8 = (bf16x8){0, 0, 0, 0, 0, 0, 0, 0};
#pragma unroll
            for (int n = 0; n < 8; ++n) bfr[n] = g4 < 2 ? *(const bf16x8*)(BB + ((size_t)g * 128 + 16 * n + fr) * 16 + 8 * g4) : zero8;
#pragma unroll
            for (int kk = 0; kk < 4; ++kk) cfr[kk] = *(const bf16x8*)(CM + ((size_t)g * 16 + fr) * 128 + 32 * kk + 8 * g4);
            { const unsigned dv = cvt_pk_bf16(Dsk[16 * g + fr], 0.f) & 0xffffu; dfr = zero8;
#pragma unroll
              for (int j = 0; j < 8; ++j) if (g4 < 2 && 8 * g4 + j == fr) dfr[j] = (short)dv; }
            const bf16_t* up = U + tokb * DM + 16 * g + 8 * g4;
            const LAS unsigned char* uring = C.lds + 100352 + pw * 4096;
            const unsigned uoff = (unsigned)(2 * fr + g4) * 16u;
            LDS_BARRIER();
            for (int i = -1; i <= S5_NS; ++i) {
                const bf16x8 uf = g4 < 2 ? *(const LAS bf16x8*)(uring + ((i + 1) & 7) * 512 + uoff) : zero8;
                const bf16x8 us = g4 < 2 ? *(const LAS bf16x8*)(uring + ((i - 1) & 7) * 512 + uoff) : zero8;
                const LAS unsigned char* src = hb + ((i - 1) & 1) * (S5_SUB * S5_HP) + fr * S5_HP + 16 * g4;
                bf16x8 hf[4];
#pragma unroll
                for (int kk = 0; kk < 4; ++kk) hf[kk] = *(const LAS bf16x8*)(src + 64 * kk);
                LAS unsigned char* dst = bub + ((i + 1) & 1) * 4096;
                f32x4 a[8];
#pragma unroll
                for (int n = 0; n < 8; ++n) a[n] = __builtin_amdgcn_mfma_f32_16x16x32_bf16(uf, bfr[n], (f32x4){0.f, 0.f, 0.f, 0.f}, 0, 0, 0);
                f32x4 y1 = __builtin_amdgcn_mfma_f32_16x16x32_bf16(dfr, us, (f32x4){0.f, 0.f, 0.f, 0.f}, 0, 0, 0);
                f32x4 y2 = __builtin_amdgcn_mfma_f32_16x16x32_bf16(cfr[2], hf[2], (f32x4){0.f, 0.f, 0.f, 0.f}, 0, 0, 0);
                y1 = __builtin_amdgcn_mfma_f32_16x16x32_bf16(cfr[0], hf[0], y1, 0, 0, 0);
                y2 = __builtin_amdgcn_mfma_f32_16x16x32_bf16(cfr[3], hf[3], y2, 0, 0, 0);
                y1 = __builtin_amdgcn_mfma_f32_16x16x32_bf16(cfr[1], hf[1], y1, 0, 0, 0);
#pragma unroll
                for (int n = 0; n < 4; ++n) { u32x4 w;
                    w.x = cvt_pk_bf16_c(a[n][0], a[n + 4][0]); w.y = cvt_pk_bf16_c(a[n][1], a[n + 4][1]); w.z = cvt_pk_bf16_c(a[n][2], a[n + 4][2]); w.w = cvt_pk_bf16_c(a[n][3], a[n + 4][3]);
                    *(LAS u32x4*)(dst + ((g4 * 64) + 16 * n + fr) * 16) = w; }
                const f32x4 y = y1 + y2;
                if (i >= 1) {
                    u32x2 o; o.x = cvt_pk_bf16_c(gelu_f(y[0]), gelu_f(y[1])); o.y = cvt_pk_bf16_c(gelu_f(y[2]), gelu_f(y[3]));
                    *(u32x2*)(Gout + (tokb + 16 * (i - 1) + fr) * DM + 16 * g + 4 * g4) = o;
                }
                LDS_BARRIER();
            }
        } else {
            const f32x2 ab = *(const f32x2*)(ABAR + ((size_t)g * 64 + lane) * 2);
            float hr = 0.f, hi = 0.f;
            LAS unsigned char* uring = C.lds + 100352 + pw * 4096;
            const bf16_t* usrc = U + (tokb + 16 * (lane >> 5) + ((lane & 31) >> 1)) * DM + 16 * g + 8 * (lane & 1);
#define S5_DMA(s0) __builtin_amdgcn_global_load_lds((const unsigned*)(usrc + (size_t)(16 * (s0)) * DM), (LAS unsigned*)(uring + ((s0) & 7) * 512), 16, 0, 0)
            S5_DMA(0); S5_DMA(2);
            asm volatile("s_waitcnt vmcnt(0)" ::: "memory");
            LDS_BARRIER();
            for (int i = -1; i <= S5_NS; ++i) {
                if ((i & 1) && i + 5 < S5_NS) S5_DMA(i + 5);
                if (i >= 0 && i < S5_NS) {
                    const LAS unsigned char* src = bub + (i & 1) * 4096 + lane * 16;
                    LAS unsigned char* dst = hb + (i & 1) * (S5_SUB * S5_HP) + lane * 4;
                    u32x4 bq[S5_SUB / 4];
#pragma unroll
                    for (int q = 0; q < S5_SUB / 4; ++q) bq[q] = *(const LAS u32x4*)(src + q * 1024);
#pragma unroll
                    for (int t = 0; t < S5_SUB; ++t) {
                        const unsigned bw = bq[t >> 2][t & 3];
                        const float nr = ab.x * hr - ab.y * hi + bflo(bw), ni = ab.x * hi + ab.y * hr + bfhi(bw);
                        hr = nr; hi = ni;
                        *(LAS unsigned*)(dst + t * S5_HP) = cvt_pk_bf16(hr, hi);
                    }
                }
                if (i + 7 < S5_NS) asm volatile("s_waitcnt vmcnt(1)" ::: "memory");
                else asm volatile("s_waitcnt vmcnt(0)" ::: "memory");
                LDS_BARRIER();
            }
#undef S5_DMA
        }
    }
}

__device__ __forceinline__ void fixup_phase(const Ctx& C, const float* ZH, const float* cw, const float* cb, bf16_t* HID) {
    const int gt = C.wg * (NWAVES * 64) + C.tid, NT = C.G * NWAVES * 64;
    const f32x4 zero4 = (f32x4){0.f, 0.f, 0.f, 0.f};
    for (int idx = gt; idx < 128 * 2 * (FF / 4); idx += NT) {
        const int c = 4 * (idx % (FF / 4)), rr = (idx / (FF / 4)) & 1, pm = idx / (2 * (FF / 4));
        const bool first = (pm & 15) == 0;
        f32x4 o[2];
#pragma unroll
        for (int hf = 0; hf < 2; ++hf) { const int cc = c + hf * FF;
            const f32x4 zt = *(const f32x4*)(ZH + (size_t)(pm * 4 + rr) * FF2 + cc);
            const f32x4 p3 = first ? zero4 : *(const f32x4*)(ZH + (size_t)((pm - 1) * 4 + 3) * FF2 + cc);
            f32x4 z1, z2;
            if (rr == 1) { z1 = *(const f32x4*)(ZH + (size_t)(pm * 4 + 0) * FF2 + cc); z2 = p3; }
            else { z1 = p3; z2 = first ? zero4 : *(const f32x4*)(ZH + (size_t)((pm - 1) * 4 + 2) * FF2 + cc); }
            o[hf] = *(const f32x4*)(cb + cc) + *(const f32x4*)(cw + 2 * FF2 + cc) * zt + *(const f32x4*)(cw + FF2 + cc) * z1 + *(const f32x4*)(cw + cc) * z2; }
        u32x2 w; w.x = cvt_pk_bf16(o[0][0] * sigmoid_f(o[0][0]) * o[1][0], o[0][1] * sigmoid_f(o[0][1]) * o[1][1]); w.y = cvt_pk_bf16(o[0][2] * sigmoid_f(o[0][2]) * o[1][2], o[0][3] * sigmoid_f(o[0][3]) * o[1][3]);
        *(u32x2*)(HID + (size_t)(pm * 256 + rr) * FF + c) = w;
    }
}

struct Args { const float* in[23]; float* out; unsigned char* ws; int ph_lo, ph_hi; };
#ifndef DUPST
#define DUPST (-1)
#endif
constexpr int PPL = 6 + (DUPST >= 0 ? 1 : 0);
constexpr int N_PHASES = 2 + PPL * DEPTH;
#ifndef PHMASK
#define PHMASK 0xFFFF
#endif
#define EN(k) (((PHMASK) >> (k)) & 1)
#ifndef DUP
#define DUP 0
#endif
#define DUPN(k) ((((DUP) >> (k)) & 1) ? 2 : 1)

template <class Epi> __device__ __forceinline__ void run_gemm(const Ctx& C, const bf16_t* A, const bf16_t* Bt, int N, int K, Epi& E, const float* hss, int np) {
    pg8::Gemm g{A, Bt, M_TOK, N, K}; pg8::StaticOrder S; S.init(M_TOK, N, C.G, C.wg, hss ? 8 : 4);
    pg8::Unit u0, u1; S.next(0, u0); u1 = u0; { const int U = (S.nwg - C.wg + C.G - 1) / C.G; if (U > 1) S.next(U - 1, u1); }
    {
        LAS float* RS = (LAS float*)(C.lds + RS_OFF);
        float rs = 1.0f;
        if (hss) { const int row = (C.tid < 256 ? u0.pm : u1.pm) * 256 + (C.tid & 255); const f32x4* p4 = (const f32x4*)(hss + (size_t)row * 64); float s = 0.f;
            for (int i = 0; i < np / 4; ++i) { const f32x4 q = p4[i]; s += (q[0] + q[1]) + (q[2] + q[3]); }
            rs = 1.0f / sqrtf(s * (1.0f / DM) + EPS); }
        RS[C.tid] = rs;
        __syncthreads();
    }
    E.pm0 = u0.pm;
    pg8::gemm_phase<Epi, pg8::StaticOrder, true, true>(C.lds, g, S, E, C.tid);
}

__device__ __forceinline__ unsigned long long ld_ptr(const LAS unsigned long long* p) {
    const unsigned long long v = *p; const unsigned lo = __builtin_amdgcn_readfirstlane((unsigned)v), hi = __builtin_amdgcn_readfirstlane((unsigned)(v >> 32));
    return ((unsigned long long)hi << 32) | lo;
}
__global__ void __launch_bounds__(NWAVES * 64, 2) mk_fwd(Args a) {
    extern __shared__ __attribute__((aligned(16))) unsigned char lds_raw[];
    unsigned char* ws = a.ws;
    float* H = a.out;
    bf16_t* XN = (bf16_t*)(ws + WS_XN); bf16_t* Z1 = (bf16_t*)(ws + WS_Z1); bf16_t* GB = (bf16_t*)(ws + WS_G); bf16_t* HID = (bf16_t*)(ws + WS_HID);
    float* VSS = (float*)(ws + WS_VSS); float* ZH = (float*)(ws + WS_ZH); float* HSS = (float*)(ws + WS_HSS);
    unsigned char* WB = ws + WS_W;

    LAS unsigned long long* PT = (LAS unsigned long long*)((LAS unsigned char*)lds_raw + MISC_OFF + 64);
    if (threadIdx.x == 0) {
#pragma unroll
        for (int i = 0; i < 23; ++i) PT[i] = (unsigned long long)a.in[i];
    }
#define IN(i) ((const float*)ld_ptr(PT + (i)))
    volatile LAS unsigned* MISC = (volatile LAS unsigned*)((LAS unsigned char*)lds_raw + MISC_OFF);
    if (threadIdx.x < 2) MISC[threadIdx.x] = 0u;
    __syncthreads();
    XcdBarrier bar; bar.bar = (unsigned*)ws; bar.x = 0; bar.st = MISC;
    if (a.ph_hi - a.ph_lo > 1) bar = xcd_barrier_post((unsigned*)ws, MISC);
    for (int ph = a.ph_lo; ph < a.ph_hi; ++ph) {
        int tid_l = threadIdx.x; asm volatile("" : "+v"(tid_l));
        Ctx C; C.lds = (LAS unsigned char*)lds_raw; C.tid = tid_l; C.lane = C.tid & 63; C.wave = __builtin_amdgcn_readfirstlane(C.tid >> 6); C.wg = blockIdx.x; C.G = gridDim.x;
        if (ph == 0) { if constexpr (EN(0)) { for (int dup = 0; dup < DUPN(0); ++dup) {
            for (int j = 0; j < 2; ++j) {
                prep_mat(C, IN(3) + (size_t)j * DM * 4096, DM, 4096, (bf16_t*)(WB + W_AIN + j * S_AIN), IN(1) + (2 * j) * DM, 0);
                prep_mat(C, IN(7) + (size_t)j * DM * DM, DM, DM, (bf16_t*)(WB + W_AOUT + j * S_AOUT), nullptr, 0);
                prep_mat(C, IN(8) + (size_t)j * DM * DM, DM, DM, (bf16_t*)(WB + W_BIN + j * S_BIN), IN(1) + (2 * j + 1) * DM, 0);
                prep_mat(C, IN(17) + (size_t)j * DM * 4096, DM, 4096, (bf16_t*)(WB + W_GLU + j * S_GLU), nullptr, 2048);
                s5_prep(C, IN(9) + j * 8192, IN(10) + j * 8192, IN(11) + j * 128, IN(12) + (size_t)j * 131072, IN(13) + (size_t)j * 131072, IN(14) + (size_t)j * 131072, IN(15) + (size_t)j * 131072,
                        (float*)(ws + WS_ABAR) + j * 16384, (bf16_t*)(ws + WS_BB) + (size_t)j * 262144, (bf16_t*)(ws + WS_CM) + (size_t)j * 262144);
                ws_prep(C, IN(5) + (size_t)j * 262144, (bf16_t*)(ws + WS_WSB) + (size_t)j * 262144);
            }
            for (int i = 0; i < DEPTH; ++i) {
                prep_mat(C, IN(18) + (size_t)i * DM * FF2, DM, FF2, (bf16_t*)(WB + W_UP + i * S_UP), IN(2) + i * DM, FF);
                prep_mat(C, IN(21) + (size_t)i * FF * DM, FF, DM, (bf16_t*)(WB + W_DOWN + i * S_DOWN), nullptr, 0);
            }
            x_in_phase(C, IN(0), XN, HSS);
        } } } else if (ph == N_PHASES - 1) {
            if constexpr (EN(11)) final_norm_phase(C, XN, HSS, IN(22), H);
        } else {
            const int L = (ph - 1) / PPL, pos = (ph - 1) % PPL, st = (DUPST >= 0 && pos > DUPST) ? pos - 1 : pos, j = L >> 1; const bool isA = (L & 1) == 0;
            const float* hss_in = HSS;
            if (st == 0) {
                if (isA) { if constexpr (EN(1)) { pg8::EpiGeluSS E{Z1, VSS, 0}; run_gemm(C, XN, (const bf16_t*)(WB + W_AIN + j * S_AIN), 4096, DM, E, hss_in, 32); } }
                else { if constexpr (EN(2)) { pg8::EpiPlainBf16 E{Z1, DM, 0}; run_gemm(C, XN, (const bf16_t*)(WB + W_BIN + j * S_BIN), DM, DM, E, hss_in, 32); } }
            } else if (st == 1) {
                if (isA) { if constexpr (EN(3)) sgu_phase(C, Z1, VSS, IN(4) + j * DM, (const bf16_t*)(ws + WS_WSB) + (size_t)j * 262144, IN(6) + j * 2048, GB); }
                else if constexpr (EN(4)) s5_phase(C, Z1, GB, (const float*)(ws + WS_ABAR) + j * 16384, (const bf16_t*)(ws + WS_BB) + (size_t)j * 262144, (const bf16_t*)(ws + WS_CM) + (size_t)j * 262144, IN(16) + j * DM);
            } else if (st == 2) {
                if (isA) { if constexpr (EN(5)) { pg8::EpiRes E{XN, HSS, 0}; run_gemm(C, GB, (const bf16_t*)(WB + W_AOUT + j * S_AOUT), DM, DM, E, nullptr, 0); } }
                else { if constexpr (EN(6)) { pg8::EpiGlu E{XN, HSS, 0}; run_gemm(C, GB, (const bf16_t*)(WB + W_GLU + j * S_GLU), 4096, DM, E, nullptr, 0); } }
            } else if (st == 3) {
                if constexpr (EN(8)) { pg8::EpiUp E{HID, ZH, IN(19) + (size_t)L * 3 * FF2, IN(20) + (size_t)L * FF2, 0}; run_gemm(C, XN, (const bf16_t*)(WB + W_UP + L * S_UP), FF2, DM, E, HSS, isA ? 32 : 64); }
            } else if (st == 4) {
                if constexpr (EN(9)) fixup_phase(C, ZH, IN(19) + (size_t)L * 3 * FF2, IN(20) + (size_t)L * FF2, HID);
            } else {
                if constexpr (EN(10)) { pg8::EpiRes E{XN, HSS, 0}; run_gemm(C, HID, (const bf16_t*)(WB + W_DOWN + L * S_DOWN), DM, FF, E, nullptr, 0); }
            }
        }
        if (ph + 1 < a.ph_hi) { for (int dup = 0; dup < DUPN(7); ++dup) {
            if (a.ph_hi > 4096) { __syncthreads(); cg::this_grid().sync(); }
            else xcd_barrier(bar); } }
    }
}

#undef IN
extern "C" void kernel_launch(void* const* d_in, const int* in_sizes, int n_in, void* d_out, int out_size, void* d_ws, size_t ws_size, hipStream_t stream) {
    static int grid = 0;
    if (grid == 0) {
        if (n_in != 23 || out_size != M_TOK * DM || ws_size < WS_END) { fprintf(stderr, "kernel_launch: unexpected shapes (n_in %d out %d ws %zu)\n", n_in, out_size, ws_size); grid = -1; return; }
        int dev = 0, cus = 0, per_cu = 0;
        hipGetDevice(&dev); hipDeviceGetAttribute(&cus, hipDeviceAttributeMultiprocessorCount, dev);
        if (hipFuncSetAttribute((const void*)mk_fwd, hipFuncAttributeMaxDynamicSharedMemorySize, LDS_BYTES) != hipSuccess) { fprintf(stderr, "kernel_launch: hipFuncSetAttribute failed\n"); grid = -1; return; }
        if (hipOccupancyMaxActiveBlocksPerMultiprocessor(&per_cu, (const void*)mk_fwd, NWAVES * 64, LDS_BYTES) != hipSuccess || per_cu < 1) { fprintf(stderr, "kernel_launch: occupancy query says %d\n", per_cu); per_cu = 1; }
        (void)hipGetLastError();
        grid = cus;
    }
    if (grid < 0) return;
    if (hipMemsetAsync(d_ws, 0, 65536, stream) != hipSuccess) { fprintf(stderr, "kernel_launch: memset failed\n"); return; }
    Args a{};
    for (int i = 0; i < 23; ++i) a.in[i] = (const float*)d_in[i];
    a.out = (float*)d_out; a.ws = (unsigned char*)d_ws;
#if MK_MULTI
    for (int p = 0; p < N_PHASES; ++p) { a.ph_lo = p; a.ph_hi = p + 1; hipLaunchKernelGGL(mk_fwd, dim3(grid), dim3(NWAVES * 64), LDS_BYTES, stream, a); }
#else
    a.ph_lo = 0; a.ph_hi = N_PHASES;
    void* args[] = {&a};
    hipError_t e = hipLaunchCooperativeKernel((const void*)mk_fwd, dim3(grid), dim3(NWAVES * 64), args, LDS_BYTES, stream);
    if (e != hipSuccess) fprintf(stderr, "kernel_launch: cooperative launch failed: %s (grid %d)\n", hipGetErrorString(e), grid);
#endif
}
```

```cpp
#include <hip/hip_runtime.h>
#include <hip/hip_cooperative_groups.h>
#include <cstdio>
#include <cstdint>
namespace cg = cooperative_groups;

#ifndef MK_MULTI
#define MK_MULTI 0
#endif

constexpr int M_TOK = 32768, DM = 2048, SEQ = 4096, NBATCH = 8, CHK = 128, FF = 5632, FF2 = 11264, DEPTH = 4;
constexpr float EPS = 1e-6f;
constexpr int NWAVES = 8;
constexpr int LDS_BYTES = 147456;
constexpr int HALO_OFF = 131072, MISC_OFF = 139264, RS_OFF = 139520;

constexpr size_t MiB = 1u << 20;
constexpr size_t WS_ABAR = 1 * MiB;
constexpr size_t WS_BB   = 2 * MiB;
constexpr size_t WS_CM   = 3 * MiB;
constexpr size_t WS_VSS  = 5 * MiB;
constexpr size_t WS_ZH   = 9 * MiB;
constexpr size_t WS_HSS  = 904 * MiB;
constexpr size_t WS_WSB  = 31 * MiB;
constexpr size_t WS_W    = 32 * MiB;
constexpr size_t W_AIN = 0, W_AOUT = 32 * MiB, W_BIN = 48 * MiB, W_GLU = 64 * MiB, W_UP = 96 * MiB, W_DOWN = 272 * MiB;
constexpr size_t S_AIN = 16 * MiB, S_AOUT = 8 * MiB, S_BIN = 8 * MiB, S_GLU = 16 * MiB, S_UP = 44 * MiB, S_DOWN = 22 * MiB;
constexpr size_t WS_XN   = 392 * MiB;
constexpr size_t WS_Z1   = 520 * MiB;
constexpr size_t WS_G    = 776 * MiB;
constexpr size_t WS_HID  = 520 * MiB;
constexpr size_t WS_H2   = 912 * MiB;
constexpr size_t WS_END  = 912 * MiB;
static_assert(W_DOWN + 4 * S_DOWN == 360 * MiB && WS_W + 360 * MiB == WS_XN, "weights map");
static_assert(WS_HID + (size_t)M_TOK * FF * 2 <= WS_HSS, "hid map");

#define LAS __attribute__((address_space(3)))
typedef unsigned short bf16_t;
typedef short bf16x8 __attribute__((ext_vector_type(8)));
typedef float f32x4 __attribute__((ext_vector_type(4)));
typedef float f32x2 __attribute__((ext_vector_type(2)));
typedef unsigned u32x4 __attribute__((ext_vector_type(4)));
typedef unsigned u32x2 __attribute__((ext_vector_type(2)));

__device__ __forceinline__ unsigned cvt_pk_bf16(float lo, float hi) { unsigned r; asm volatile("v_cvt_pk_bf16_f32 %0, %1, %2" : "=v"(r) : "v"(lo), "v"(hi)); return r; }
typedef __bf16 bf16x2_t __attribute__((ext_vector_type(2)));
__device__ __forceinline__ unsigned cvt_pk_bf16_c(float lo, float hi) { f32x2 v = {lo, hi}; bf16x2_t b = __builtin_convertvector(v, bf16x2_t); return __builtin_bit_cast(unsigned, b); }
__device__ __forceinline__ float bf2f(unsigned short b) { return __builtin_bit_cast(float, ((unsigned)b) << 16); }
__device__ __forceinline__ float bflo(unsigned w) { return __builtin_bit_cast(float, w << 16); }
__device__ __forceinline__ float bfhi(unsigned w) { return __builtin_bit_cast(float, w & 0xffff0000u); }
__device__ __forceinline__ float gelu_f(float x) {
    const float t = x * (1.0f + 0.044715f * x * x) * (-1.5957691216057308f * 1.4426950408889634f);
    return x * __builtin_amdgcn_rcpf(1.0f + __builtin_amdgcn_exp2f(t));
}
__device__ __forceinline__ f32x4 gelu4(f32x4 v) { return (f32x4){gelu_f(v[0]), gelu_f(v[1]), gelu_f(v[2]), gelu_f(v[3])}; }
__device__ __forceinline__ float sigmoid_f(float x) { return __builtin_amdgcn_rcpf(1.0f + __builtin_amdgcn_exp2f(-1.4426950408889634f * x)); }
__device__ __forceinline__ float wave_sum(float v) {
#pragma unroll
    for (int o = 1; o < 64; o <<= 1) v += __shfl_xor(v, o);
    return v;
}
__device__ __forceinline__ float dpp_ror1(float x) { return __builtin_bit_cast(float, __builtin_amdgcn_update_dpp(0, __builtin_bit_cast(int, x), 0x121, 0xF, 0xF, false)); }
__device__ __forceinline__ float dpp_ror2(float x) { return __builtin_bit_cast(float, __builtin_amdgcn_update_dpp(0, __builtin_bit_cast(int, x), 0x122, 0xF, 0xF, false)); }
__device__ __forceinline__ float dpp_shr1_old(float old, float x) { return __builtin_bit_cast(float, __builtin_amdgcn_update_dpp(__builtin_bit_cast(int, old), __builtin_bit_cast(int, x), 0x111, 0xF, 0xF, false)); }
__device__ __forceinline__ float dpp_shr2_old(float old, float x) { return __builtin_bit_cast(float, __builtin_amdgcn_update_dpp(__builtin_bit_cast(int, old), __builtin_bit_cast(int, x), 0x112, 0xF, 0xF, false)); }
template <int CTRL> __device__ __forceinline__ float dpp_z(float x) { return __builtin_bit_cast(float, __builtin_amdgcn_update_dpp(0, __builtin_bit_cast(int, x), CTRL, 0xF, 0xF, true)); }
#define LDS_BARRIER() do { asm volatile("s_waitcnt lgkmcnt(0)" ::: "memory"); __builtin_amdgcn_s_barrier(); asm volatile("" ::: "memory"); } while (0)

#define XB_TMO      128
#define XB_XCNT(j)  (256  + 64 * (j))
#define XB_XSUB(j)  (1280 + 64 * (j))
#define XB_XGEN(j)  (2304 + 64 * (j))
#define XB_TOP      3328
#define XB_TOPGEN   3392
#define XCD_BAR_WORDS 3456
#define XB_SPIN_CAP (1u << 18)

__device__ __forceinline__ unsigned xb_ld(unsigned* p)              { return __hip_atomic_load(p, __ATOMIC_RELAXED, __HIP_MEMORY_SCOPE_AGENT); }
__device__ __forceinline__ unsigned xb_add(unsigned* p, unsigned v) { return __hip_atomic_fetch_add(p, v, __ATOMIC_RELAXED, __HIP_MEMORY_SCOPE_AGENT); }
__device__ __forceinline__ unsigned xb_xcc_id() { return (unsigned)__builtin_amdgcn_s_getreg((3 << 11) | 20) & 0xFu; }
#define XB_SPIN(cond, bar) do { unsigned _sp = 0; while (cond) { __builtin_amdgcn_s_sleep(1); \
    if ((++_sp & 255u) == 0u) { if (xb_ld(&(bar)[XB_TMO])) break; if (_sp > XB_SPIN_CAP) { atomicAdd(&(bar)[XB_TMO], 1u); break; } } } } while (0)

struct XcdBarrier {
    unsigned* bar; unsigned x;
    volatile LAS unsigned* st;
};

__device__ __forceinline__ XcdBarrier xcd_barrier_post(unsigned* bar, volatile LAS unsigned* st) {
    XcdBarrier b; b.bar = bar; b.x = xb_xcc_id(); b.st = st;
    if (threadIdx.x == 0) (void)xb_add(&bar[XB_XCNT(b.x)], 1u);
    return b;
}
__device__ __forceinline__ void xcd_barrier_complete(unsigned* bar, unsigned x, unsigned& nloc, unsigned& nx) {
    const unsigned G = gridDim.x * gridDim.y * gridDim.z;
    unsigned sum, cnt, mine, sp = 0u;
    for (;;) {
        sum = 0u; cnt = 0u; mine = 0u;
#pragma unroll
        for (unsigned j = 0; j < 16; ++j) { const unsigned c = xb_ld(&bar[XB_XCNT(j)]); sum += c; cnt += (c > 0u) ? 1u : 0u; mine = (j == x) ? c : mine; }
        if (sum == G) break;
        __builtin_amdgcn_s_sleep(1);
        if ((++sp & 255u) == 0u) { if (xb_ld(&bar[XB_TMO])) break; if (sp > XB_SPIN_CAP) { atomicAdd(&bar[XB_TMO], 1u); break; } }
    }
    nloc = mine > 0u ? mine : 1u; nx = cnt > 0u ? cnt : 1u;
}

__device__ __forceinline__ void xcd_barrier(const XcdBarrier& b) {
    asm volatile("s_waitcnt vmcnt(0)" ::: "memory");
    __syncthreads();
    if (threadIdx.x == 0) {
        unsigned* bar = b.bar;
        __builtin_amdgcn_s_waitcnt(0);
        unsigned nloc = b.st[0], nx = b.st[1];
        if (nloc == 0u) { xcd_barrier_complete(bar, b.x, nloc, nx); b.st[0] = nloc; b.st[1] = nx; }
        const unsigned old = xb_add(&bar[XB_XSUB(b.x)], 1u);
        const unsigned gen = old / nloc;
        if (old + 1u == (gen + 1u) * nloc) {
            __builtin_amdgcn_fence(__ATOMIC_RELEASE, "agent");
            asm volatile("s_waitcnt vmcnt(0)" ::: "memory");
            const unsigned og = xb_add(&bar[XB_TOP], 1u);
            const unsigned tg = og / nx;
            if (og + 1u == (tg + 1u) * nx) xb_add(&bar[XB_TOPGEN], 1u);
            else XB_SPIN(xb_ld(&bar[XB_TOPGEN]) == tg, bar);
            __builtin_amdgcn_fence(__ATOMIC_ACQUIRE, "agent");
            xb_add(&bar[XB_XGEN(b.x)], 1u);
            asm volatile("s_waitcnt vmcnt(0)" ::: "memory");
        } else {
            XB_SPIN(xb_ld(&bar[XB_XGEN(b.x)]) == gen, bar);
            __builtin_amdgcn_fence(__ATOMIC_ACQUIRE, "agent");
            asm volatile("s_waitcnt vmcnt(0)" ::: "memory");
        }
    }
    __syncthreads();
}

namespace pg8 {
#define PG8_LAS __attribute__((address_space(3)))
typedef unsigned short bf16_t;
typedef short bf16x8 __attribute__((ext_vector_type(8)));
typedef float f32x4 __attribute__((ext_vector_type(4)));
typedef unsigned u32x4 __attribute__((ext_vector_type(4)));
constexpr int BM = 256, BK = 64, HALF = 128, HTB = HALF * BK * 2  , STAGE_BYTES = 8 * HTB, NXCD = 8, WGM = 8;

__host__ __device__ __forceinline__ int lds_byte(int r, int c) { const int st = (r >> 4) * 2 + (c >> 5), rr = r & 15, cc = c & 31, ob = rr * 64 + cc * 2; return st * 1024 + (ob ^ (((ob >> 9) & 1) << 5)); }
__host__ __device__ __forceinline__ void stage_rc(int b, int& R, int& C) { const int st = b / 1024, sb = b % 1024, swz = sb ^ (((sb >> 9) & 1) << 5); R = (st >> 1) * 16 + swz / 64; C = (st & 1) * 32 + (swz % 64) / 2; }
__host__ __device__ __forceinline__ int perm32(int rho) { const int n = rho >> 4, i = rho & 15; return 8 * (i >> 2) + 4 * n + (i & 3); }

struct Unit { int pm, pn; };
struct Gemm { const bf16_t* A; const bf16_t* Bt; int M, N, K; };

struct StaticOrder {
    int nM, nN, nwg, G, c, wgm;
    __host__ __device__ void init(int M, int N, int G_, int c_, int wgm_ = WGM) { nM = M / BM; nN = N / BM; nwg = nM * nN; G = G_; c = c_; wgm = wgm_; }
    __host__ __device__ bool next(int i, Unit& u) const {
        const long L = (long)i * G + c; if (L >= nwg) return false;
        int wgid = (int)L; { const int q = nwg / NXCD, r = nwg % NXCD, xcd = wgid % NXCD, off = wgid / NXCD; wgid = (xcd < r ? xcd * (q + 1) : r * (q + 1) + (xcd - r) * q) + off; }
        const int nig = wgm * nN, gid = wgid / nig, fm = gid * wgm, gsz = (nM - fm) < wgm ? (nM - fm) : wgm;
        u.pm = fm + ((wgid % nig) % gsz); u.pn = (wgid % nig) / gsz; return true;
    }
    __device__ __forceinline__ void a_ready(const Unit&) const {}
    __device__ __forceinline__ void done(const Unit&) const {}
};


__device__ __forceinline__ void load_rs(float (&rs)[2][4], PG8_LAS unsigned char* lds, const Unit& u, int pm0, int wr, int fr) {
    const PG8_LAS float* RS = (const PG8_LAS float*)(lds + RS_OFF) + (u.pm != pm0 ? 256 : 0) + wr * 64 + fr;
#pragma unroll
    for (int ai = 0; ai < 2; ++ai)
#pragma unroll
        for (int m = 0; m < 4; ++m) rs[ai][m] = RS[ai * HALF + m * 16];
}
struct EpiGeluSS {
    static constexpr bool PERM = true, AFTER_DRAIN = false, APERM = false;
    bf16_t* O; float* vss; int pm0;
    __device__ __forceinline__ void operator()(f32x4 (&acc)[2][2][4][2], const Unit& u, int wr, int wc, int fr, int fq, PG8_LAS unsigned char* lds) const {
        const int row0 = u.pm * BM + wr * 64 + fr, col0 = u.pn * BM + wc * 32 + 8 * fq;
        const bool isv = u.pn >= 8;
        float rs[2][4]; load_rs(rs, lds, u, pm0, wr, fr);
#pragma unroll
        for (int ai = 0; ai < 2; ++ai)
#pragma unroll
            for (int m = 0; m < 4; ++m) { const int row = row0 + ai * HALF + m * 16; bf16_t* rowp = O + (size_t)row * 4096 + col0; float ss = 0.f;
#pragma unroll
                for (int bj = 0; bj < 2; ++bj) { const f32x4 v0 = gelu4(acc[ai][bj][m][0] * rs[ai][m]), v1 = gelu4(acc[ai][bj][m][1] * rs[ai][m]);
                    ss += (v0[0] * v0[0] + v0[1] * v0[1]) + (v0[2] * v0[2] + v0[3] * v0[3]) + (v1[0] * v1[0] + v1[1] * v1[1]) + (v1[2] * v1[2] + v1[3] * v1[3]);
                    u32x4 w; w.x = cvt_pk_bf16(v0[0], v0[1]); w.y = cvt_pk_bf16(v0[2], v0[3]); w.z = cvt_pk_bf16(v1[0], v1[1]); w.w = cvt_pk_bf16(v1[2], v1[3]);
                    *(u32x4*)(rowp + bj * HALF) = w; }
                if (isv) { ss += __shfl_xor(ss, 16); ss += __shfl_xor(ss, 32); if (fq == 0) vss[(size_t)row * 32 + (u.pn - 8) * 4 + wc] = ss; } }
    }
};
struct EpiPlainBf16 {
    static constexpr bool PERM = true, AFTER_DRAIN = false, APERM = false;
    bf16_t* O; int ldc; int pm0;
    __device__ __forceinline__ void operator()(f32x4 (&acc)[2][2][4][2], const Unit& u, int wr, int wc, int fr, int fq, PG8_LAS unsigned char* lds) const {
        const int row0 = u.pm * BM + wr * 64 + fr, col0 = u.pn * BM + wc * 32 + 8 * fq;
        float rs[2][4]; load_rs(rs, lds, u, pm0, wr, fr);
#pragma unroll
        for (int ai = 0; ai < 2; ++ai)
#pragma unroll
            for (int m = 0; m < 4; ++m) { bf16_t* rowp = O + (size_t)(row0 + ai * HALF + m * 16) * ldc + col0;
#pragma unroll
                for (int bj = 0; bj < 2; ++bj) { const f32x4 v0 = acc[ai][bj][m][0] * rs[ai][m], v1 = acc[ai][bj][m][1] * rs[ai][m];
                    u32x4 w; w.x = cvt_pk_bf16(v0[0], v0[1]); w.y = cvt_pk_bf16(v0[2], v0[3]); w.z = cvt_pk_bf16(v1[0], v1[1]); w.w = cvt_pk_bf16(v1[2], v1[3]);
                    *(u32x4*)(rowp + bj * HALF) = w; } }
    }
};
__device__ __forceinline__ f32x4 bf4lo(u32x4 r) { return (f32x4){bflo(r.x), bfhi(r.x), bflo(r.y), bfhi(r.y)}; }
__device__ __forceinline__ f32x4 bf4hi(u32x4 r) { return (f32x4){bflo(r.z), bfhi(r.z), bflo(r.w), bfhi(r.w)}; }
struct EpiRes {
    static constexpr bool PERM = true, AFTER_DRAIN = false, APERM = false;
    bf16_t* xn; float* hss; int pm0;
    __device__ __forceinline__ void operator()(f32x4 (&acc)[2][2][4][2], const Unit& u, int wr, int wc, int fr, int fq, PG8_LAS unsigned char*) const {
        const int row0 = u.pm * BM + wr * 64 + fr, col0 = u.pn * BM + wc * 32 + 8 * fq;
        u32x4 rb[8][2];
#define RES_LOAD(g) do { const size_t off_ = (size_t)(row0 + ((g) >> 2) * HALF + ((g) & 3) * 16) * DM + col0; rb[g][0] = *(const u32x4*)(xn + off_); rb[g][1] = *(const u32x4*)(xn + off_ + HALF); } while (0)
        RES_LOAD(0); RES_LOAD(1); RES_LOAD(2); RES_LOAD(3); RES_LOAD(4); RES_LOAD(5); RES_LOAD(6); RES_LOAD(7);
        asm volatile("" ::: "memory");
#pragma unroll
        for (int g = 0; g < 8; ++g) { const int ai = g >> 2, m = g & 3;
            const int row = row0 + ai * HALF + m * 16; const size_t off = (size_t)row * DM + col0; float ss = 0.f;
#pragma unroll
            for (int bj = 0; bj < 2; ++bj) {
                const f32x4 o0 = bf4lo(rb[g][bj]) + acc[ai][bj][m][0], o1 = bf4hi(rb[g][bj]) + acc[ai][bj][m][1];
                ss += (o0[0] * o0[0] + o0[1] * o0[1]) + (o0[2] * o0[2] + o0[3] * o0[3]) + (o1[0] * o1[0] + o1[1] * o1[1]) + (o1[2] * o1[2] + o1[3] * o1[3]);
                u32x4 w; w.x = cvt_pk_bf16(o0[0], o0[1]); w.y = cvt_pk_bf16(o0[2], o0[3]); w.z = cvt_pk_bf16(o1[0], o1[1]); w.w = cvt_pk_bf16(o1[2], o1[3]);
                *(u32x4*)(xn + off + bj * HALF) = w; }
            ss += __shfl_xor(ss, 16); ss += __shfl_xor(ss, 32); if (fq == 0) hss[(size_t)row * 64 + u.pn * 4 + wc] = ss;
            asm volatile("" ::: "memory"); }
#undef RES_LOAD
    }
};
struct EpiGlu {
    static constexpr bool PERM = true, AFTER_DRAIN = false, APERM = false;
    bf16_t* xn; float* hss; int pm0;
    __device__ __forceinline__ void operator()(f32x4 (&acc)[2][2][4][2], const Unit& u, int wr, int wc, int fr, int fq, PG8_LAS unsigned char*) const {
        const int row0 = u.pm * BM + wr * 64 + fr, col0 = u.pn * HALF + wc * 32 + 8 * fq;
        u32x4 rb[8];
#define RES_LOAD(g) do { const size_t off_ = (size_t)(row0 + ((g) >> 2) * HALF + ((g) & 3) * 16) * DM + col0; rb[g] = *(const u32x4*)(xn + off_); } while (0)
        RES_LOAD(0); RES_LOAD(1); RES_LOAD(2); RES_LOAD(3); RES_LOAD(4); RES_LOAD(5); RES_LOAD(6); RES_LOAD(7);
        asm volatile("" ::: "memory");
#pragma unroll
        for (int g = 0; g < 8; ++g) { const int ai = g >> 2, m = g & 3;
            const int row = row0 + ai * HALF + m * 16; const size_t off = (size_t)row * DM + col0; float ss = 0.f;
            f32x4 o[2]; o[0] = bf4lo(rb[g]); o[1] = bf4hi(rb[g]);
#pragma unroll
            for (int n = 0; n < 2; ++n) { const f32x4 ga = acc[ai][0][m][n], gb = acc[ai][1][m][n];
#pragma unroll
                for (int j = 0; j < 4; ++j) o[n][j] += ga[j] * sigmoid_f(gb[j]);
                ss += (o[n][0] * o[n][0] + o[n][1] * o[n][1]) + (o[n][2] * o[n][2] + o[n][3] * o[n][3]); }
            u32x4 w; w.x = cvt_pk_bf16(o[0][0], o[0][1]); w.y = cvt_pk_bf16(o[0][2], o[0][3]); w.z = cvt_pk_bf16(o[1][0], o[1][1]); w.w = cvt_pk_bf16(o[1][2], o[1][3]);
            *(u32x4*)(xn + off) = w;
            ss += __shfl_xor(ss, 16); ss += __shfl_xor(ss, 32); if (fq == 0) hss[(size_t)row * 64 + u.pn * 4 + wc] = ss;
            asm volatile("" ::: "memory"); }
#undef RES_LOAD
    }
};
struct EpiUp {
    static constexpr bool PERM = true, AFTER_DRAIN = false, APERM = true;
    bf16_t* HID; float* ZH; const float* cw; const float* cb; int pm0;
    __device__ __forceinline__ void operator()(f32x4 (&acc)[2][2][4][2], const Unit& u, int wr, int wc, int fr, int fq, PG8_LAS unsigned char* lds) const {
        PG8_LAS float* halo = (PG8_LAS float*)(lds + HALO_OFF);
        const int tcol = wc * 32 + 8 * fq;
        const int tl0 = 8 * (16 * wr + fr);
        { const PG8_LAS float* RS = (const PG8_LAS float*)(lds + RS_OFF) + (u.pm != pm0 ? 256 : 0) + tl0;
          const f32x4 ra = *(const PG8_LAS f32x4*)RS, rb = *(const PG8_LAS f32x4*)(RS + 4);
#pragma unroll
          for (int bj = 0; bj < 2; ++bj)
#pragma unroll
            for (int n = 0; n < 2; ++n) {
#pragma unroll
              for (int m = 0; m < 4; ++m) { acc[0][bj][m][n] = acc[0][bj][m][n] * ra[m]; acc[1][bj][m][n] = acc[1][bj][m][n] * rb[m]; } } }
        if (wr == 0 && fr == 15) {
#pragma unroll
            for (int bj = 0; bj < 2; ++bj)
#pragma unroll
                for (int n = 0; n < 2; ++n) { *(PG8_LAS f32x4*)(halo + bj * HALF + tcol + 4 * n) = acc[1][bj][2][n]; *(PG8_LAS f32x4*)(halo + 256 + bj * HALF + tcol + 4 * n) = acc[1][bj][3][n]; }
        }
        if (wr == 0 && fr == 0) {
#pragma unroll
            for (int bj = 0; bj < 2; ++bj)
#pragma unroll
                for (int n = 0; n < 2; ++n) { float* z = ZH + (size_t)(u.pm * 4) * FF2 + bj * FF + u.pn * HALF + tcol + 4 * n; *(f32x4*)z = acc[0][bj][0][n]; *(f32x4*)(z + FF2) = acc[0][bj][1][n]; }
        }
        if (wr == 1 && fr == 15) {
#pragma unroll
            for (int bj = 0; bj < 2; ++bj)
#pragma unroll
                for (int n = 0; n < 2; ++n) { float* z = ZH + (size_t)(u.pm * 4 + 2) * FF2 + bj * FF + u.pn * HALF + tcol + 4 * n; *(f32x4*)z = acc[1][bj][2][n]; *(f32x4*)(z + FF2) = acc[1][bj][3][n]; }
        }
        LDS_BARRIER();
#pragma unroll
        for (int n = 0; n < 2; ++n)
#pragma unroll
            for (int bj = 0; bj < 2; ++bj) {
                const int c = bj * FF + u.pn * HALF + tcol + 4 * n;
                const f32x4 w0 = *(const f32x4*)(cw + c), w1 = *(const f32x4*)(cw + FF2 + c), w2 = *(const f32x4*)(cw + 2 * FF2 + c), bb = *(const f32x4*)(cb + c);
                f32x4 h6 = (f32x4){0.f, 0.f, 0.f, 0.f}, h7 = h6;
                if (wr == 1) { h6 = *(const PG8_LAS f32x4*)(halo + bj * HALF + tcol + 4 * n); h7 = *(const PG8_LAS f32x4*)(halo + 256 + bj * HALF + tcol + 4 * n); }
                f32x4 s6, s7;
#pragma unroll
                for (int j = 0; j < 4; ++j) { s6[j] = dpp_shr1_old(h6[j], acc[1][bj][2][n][j]); s7[j] = dpp_shr1_old(h7[j], acc[1][bj][3][n][j]); }
#pragma unroll
                for (int r8 = 7; r8 >= 0; --r8) {
                    const f32x4 zc = acc[r8 >> 2][bj][r8 & 3][n];
                    const f32x4 z1 = (r8 >= 1) ? acc[(r8 >= 1 ? r8 - 1 : 0) >> 2][bj][(r8 >= 1 ? r8 - 1 : 0) & 3][n] : s7;
                    const f32x4 z2 = (r8 >= 2) ? acc[(r8 >= 2 ? r8 - 2 : 0) >> 2][bj][(r8 >= 2 ? r8 - 2 : 0) & 3][n] : (r8 == 1 ? s7 : s6);
                    f32x4 r;
#pragma unroll
                    for (int j = 0; j < 4; ++j) r[j] = __builtin_fmaf(w0[j], z2[j], __builtin_fmaf(w1[j], z1[j], __builtin_fmaf(w2[j], zc[j], bb[j])));
                    acc[r8 >> 2][bj][r8 & 3][n] = r;
                    asm volatile("" : "+v"(acc[r8 >> 2][bj][r8 & 3][n]));
                }
                asm volatile("" ::: "memory");
            }
#pragma unroll
        for (int ai = 0; ai < 2; ++ai)
#pragma unroll
            for (int m = 0; m < 4; ++m) {
                bf16_t* rowp = HID + (size_t)(u.pm * BM + tl0 + 4 * ai + m) * FF + u.pn * HALF + tcol;
                float o[8];
#pragma unroll
                for (int n = 0; n < 2; ++n)
#pragma unroll
                    for (int j = 0; j < 4; ++j) { const float g = acc[ai][0][m][n][j], v = acc[ai][1][m][n][j]; o[4 * n + j] = g * sigmoid_f(g) * v; }
                u32x4 w; w.x = cvt_pk_bf16(o[0], o[1]); w.y = cvt_pk_bf16(o[2], o[3]); w.z = cvt_pk_bf16(o[4], o[5]); w.w = cvt_pk_bf16(o[6], o[7]);
                *(u32x4*)rowp = w;
            }
    }
};
template <class Epi, class Sched, bool ALIGN_EPI = false, bool SP2 = false>
__device__ __forceinline__ void gemm_phase(PG8_LAS unsigned char* lds, const Gemm g, const Sched& S, const Epi& E, const int tid_in) {
    const int tid = tid_in, wid = __builtin_amdgcn_readfirstlane(tid >> 6), lane = tid & 63, wr = wid >> 2, wc = wid & 3, fr = lane & 15, fq = lane >> 4;
    const int K = g.K, nt = K / BK;
    unsigned voffA[2], voffB[2];
#pragma unroll
    for (int i = 0; i < 2; ++i) { int R, C; stage_rc(tid * 16 + i * 8192, R, C); const int Rb = Epi::PERM ? ((R & ~31) + perm32(R & 31)) : R;
        const int Ra = Epi::APERM ? (8 * (16 * ((R >> 6) & 1) + (R & 15)) + ((R >> 4) & 3)) : R; voffA[i] = (unsigned)(Ra * K + C) * 2u; voffB[i] = (unsigned)(Rb * K + C) * 2u; }
    const size_t kstep = (size_t)(BK * 2);
    const size_t hstep = (size_t)HALF * K * 2;
    const size_t tstep = 2 * hstep;
    const size_t hstepA = Epi::APERM ? (size_t)4 * K * 2 : hstep;
    const unsigned ldsw = (unsigned)wid * 1024u;
    const int aoff = lds_byte(wr * 64 + fr, fq * 8), boff = lds_byte(wc * 32 + fr, fq * 8);
#define PG8_SA(b, h) (((b) * 2 + (h)) * HTB)
#define PG8_SB(b, h) ((4 + (b) * 2 + (h)) * HTB)
#define PG8_STAGE(bufoff, gbase, voff) do { _Pragma("unroll") for (int _i = 0; _i < 2; ++_i) \
        __builtin_amdgcn_global_load_lds((const unsigned*)((const char*)(gbase) + (voff)[_i]), (PG8_LAS unsigned*)(lds + (bufoff) + ldsw + _i * 8192), 16, 0, 0); } while (0)
#define PG8_LDA(dst, b, h) do { _Pragma("unroll") for (int m = 0; m < 4; ++m) _Pragma("unroll") for (int k = 0; k < 2; ++k) dst[m][k] = *(const PG8_LAS bf16x8*)(lds + PG8_SA(b, h) + aoff + m * 2048 + k * 1024); } while (0)
#define PG8_LDB(dst, b, h) do { _Pragma("unroll") for (int n = 0; n < 2; ++n) _Pragma("unroll") for (int k = 0; k < 2; ++k) dst[n][k] = *(const PG8_LAS bf16x8*)(lds + PG8_SB(b, h) + boff + n * 2048 + k * 1024); } while (0)
#define PG8_MMA(ai, bj, At, Bt) do { __builtin_amdgcn_s_setprio(3); _Pragma("unroll") for (int m = 0; m < 4; ++m) _Pragma("unroll") for (int n = 0; n < 2; ++n) _Pragma("unroll") for (int k = 0; k < 2; ++k) \
        acc[ai][bj][m][n] = __builtin_amdgcn_mfma_f32_16x16x32_bf16(Bt[n][k], At[m][k], acc[ai][bj][m][n], 0, 0, 0); __builtin_amdgcn_s_setprio(0); } while (0)
#define PG8_WAIT_V(n) asm volatile("s_waitcnt vmcnt(" #n ")" ::: "memory")
#define PG8_WAIT_L(n) asm volatile("s_waitcnt lgkmcnt(" #n ")" ::: "memory")
#define PG8_BAR __builtin_amdgcn_s_barrier()
#define PG8_SCHED __builtin_amdgcn_sched_barrier(0)
    Unit cur, nxt; int ui = 0;
    if (!S.next(0, cur)) return;
    f32x4 acc[2][2][4][2];
#pragma unroll
    for (int a = 0; a < 2; ++a)
#pragma unroll
        for (int b = 0; b < 2; ++b)
#pragma unroll
            for (int m = 0; m < 4; ++m)
#pragma unroll
                for (int n = 0; n < 2; ++n) acc[a][b][m][n] = (f32x4){0.f, 0.f, 0.f, 0.f};
    bf16x8 At[4][2], B0[2][2], B1[2][2];
    const char* cA = (const char*)g.A + (size_t)cur.pm * tstep; const char* cB = (const char*)g.Bt + (size_t)cur.pn * tstep;
    S.a_ready(cur);
    if constexpr (SP2) {
        PG8_STAGE(PG8_SB(0, 0), cB, voffB); PG8_STAGE(PG8_SB(0, 1), cB + hstep, voffB); PG8_STAGE(PG8_SA(0, 0), cA, voffA); PG8_STAGE(PG8_SA(0, 1), cA + hstepA, voffA);
        if (wr == 1) PG8_BAR;
        PG8_WAIT_V(2); PG8_BAR;
        PG8_STAGE(PG8_SB(1, 0), cB + kstep, voffB); PG8_STAGE(PG8_SA(1, 0), cA + kstep, voffA); PG8_STAGE(PG8_SB(1, 1), cB + hstep + kstep, voffB);
        PG8_WAIT_V(6); PG8_BAR;
    } else {
        PG8_STAGE(PG8_SB(0, 0), cB, voffB); PG8_STAGE(PG8_SA(0, 0), cA, voffA); PG8_STAGE(PG8_SB(0, 1), cB + hstep, voffB); PG8_STAGE(PG8_SA(0, 1), cA + hstepA, voffA);
        if (wr == 1) PG8_BAR;
        PG8_WAIT_V(4); PG8_BAR;
        PG8_STAGE(PG8_SB(1, 0), cB + kstep, voffB); PG8_STAGE(PG8_SA(1, 0), cA + kstep, voffA); PG8_STAGE(PG8_SB(1, 1), cB + hstep + kstep, voffB);
        PG8_WAIT_V(6); PG8_BAR;
    }
    for (;;) {
        const bool has_next = S.next(ui + 1, nxt);
        const char* nA = has_next ? (const char*)g.A + (size_t)nxt.pm * tstep : cA; const char* nB = has_next ? (const char*)g.Bt + (size_t)nxt.pn * tstep : cB;
        for (int t = 0; t < nt; t += 2) {
            const bool last = (t == nt - 2);
            const char* a1 = cA + (size_t)(t + 1) * kstep;
            const char* a2 = last ? nA : cA + (size_t)(t + 2) * kstep; const char* b2 = last ? nB : cB + (size_t)(t + 2) * kstep;
            const char* a3 = a2 + kstep; const char* b3 = b2 + kstep;
            if (last && has_next) S.a_ready(nxt);
            if constexpr (SP2) {
            PG8_LDB(B0, 0, 0); PG8_LDB(B1, 0, 1); PG8_SCHED; PG8_LDA(At, 0, 0); PG8_STAGE(PG8_SA(1, 1), a1 + hstepA, voffA);
            PG8_WAIT_V(8); PG8_WAIT_L(0); PG8_BAR; PG8_MMA(0, 0, At, B0); PG8_MMA(0, 1, At, B1); PG8_BAR; PG8_SCHED;
            PG8_LDA(At, 0, 1); PG8_STAGE(PG8_SB(0, 0), b2, voffB); PG8_STAGE(PG8_SB(0, 1), b2 + hstep, voffB); PG8_STAGE(PG8_SA(0, 0), a2, voffA);
            PG8_WAIT_V(8); PG8_WAIT_L(0); PG8_BAR; PG8_MMA(1, 0, At, B0); PG8_MMA(1, 1, At, B1); PG8_BAR; PG8_SCHED;
            PG8_LDB(B0, 1, 0); PG8_LDB(B1, 1, 1); PG8_SCHED; PG8_LDA(At, 1, 0); PG8_STAGE(PG8_SA(0, 1), a2 + hstepA, voffA);
            PG8_WAIT_V(8); PG8_WAIT_L(0); PG8_BAR; PG8_MMA(0, 0, At, B0); PG8_MMA(0, 1, At, B1); PG8_BAR; PG8_SCHED;
            PG8_LDA(At, 1, 1); PG8_STAGE(PG8_SB(1, 0), b3, voffB); PG8_STAGE(PG8_SB(1, 1), b3 + hstep, voffB); PG8_STAGE(PG8_SA(1, 0), a3, voffA);
            PG8_WAIT_V(8); PG8_WAIT_L(0); PG8_BAR; PG8_MMA(1, 0, At, B0); PG8_MMA(1, 1, At, B1); PG8_BAR; PG8_SCHED;
            } else {
            PG8_LDB(B0, 0, 0); PG8_SCHED; PG8_LDA(At, 0, 0); PG8_STAGE(PG8_SA(1, 1), a1 + hstepA, voffA);
            PG8_WAIT_L(8); PG8_BAR; PG8_WAIT_L(0); PG8_MMA(0, 0, At, B0); PG8_BAR; PG8_SCHED;
            PG8_LDB(B1, 0, 1); PG8_STAGE(PG8_SB(0, 0), b2, voffB);
            PG8_BAR; PG8_WAIT_L(0); PG8_MMA(0, 1, At, B1); PG8_BAR;
            PG8_LDA(At, 0, 1); PG8_STAGE(PG8_SA(0, 0), a2, voffA);
            PG8_BAR; PG8_WAIT_L(0); PG8_MMA(1, 0, At, B0); PG8_BAR; PG8_SCHED;
            PG8_STAGE(PG8_SB(0, 1), b2 + hstep, voffB);
            PG8_WAIT_V(6); PG8_BAR; PG8_MMA(1, 1, At, B1); PG8_BAR;
            PG8_LDB(B0, 1, 0); PG8_SCHED; PG8_LDA(At, 1, 0); PG8_STAGE(PG8_SA(0, 1), a2 + hstepA, voffA);
            PG8_WAIT_L(8); PG8_BAR; PG8_WAIT_L(0); PG8_MMA(0, 0, At, B0); PG8_BAR; PG8_SCHED;
            PG8_LDB(B1, 1, 1); PG8_STAGE(PG8_SB(1, 0), b3, voffB);
            PG8_BAR; PG8_WAIT_L(0); PG8_MMA(0, 1, At, B1); PG8_BAR;
            PG8_LDA(At, 1, 1); PG8_STAGE(PG8_SA(1, 0), a3, voffA);
            PG8_BAR; PG8_WAIT_L(0); PG8_MMA(1, 0, At, B0); PG8_BAR; PG8_SCHED;
            PG8_STAGE(PG8_SB(1, 1), b3 + hstep, voffB);
            PG8_WAIT_V(6); PG8_BAR; PG8_MMA(1, 1, At, B1); PG8_BAR;
            }
        }
        if constexpr (ALIGN_EPI) { if (wr == 0) PG8_BAR; }
        if constexpr (!Epi::AFTER_DRAIN) { E(acc, cur, wr, wc, fr, fq, lds); S.done(cur); }
        if (!has_next) break;
#pragma unroll
        for (int a = 0; a < 2; ++a)
#pragma unroll
            for (int b = 0; b < 2; ++b)
#pragma unroll
                for (int m = 0; m < 4; ++m)
#pragma unroll
                    for (int n = 0; n < 2; ++n) acc[a][b][m][n] = (f32x4){0.f, 0.f, 0.f, 0.f};
        cur = nxt; cA = nA; cB = nB; ++ui;
        if constexpr (ALIGN_EPI) { if (wr == 1) PG8_BAR; }
    }
    PG8_WAIT_V(0);
    if constexpr (!ALIGN_EPI) { if (wr == 0) PG8_BAR; }
    PG8_BAR;
    if constexpr (Epi::AFTER_DRAIN) { E.fused(acc, cur, wr, wc, fr, fq, lds, wid, lane); S.done(cur); }
#undef PG8_SA
#undef PG8_SB
#undef PG8_STAGE
#undef PG8_LDA
#undef PG8_LDB
#undef PG8_MMA
#undef PG8_WAIT_V
#undef PG8_WAIT_L
#undef PG8_BAR
#undef PG8_SCHED
}
}

struct Ctx { LAS unsigned char* lds; int tid, lane, wave, wg, G; };

__device__ __forceinline__ void transpose_load(float (&tv)[32], const float* W, int N, int item, int lane) {
    const int nblk = N / 32, kb = item / nblk, nb = item % nblk, k0 = 64 * kb, n0 = 32 * nb;
    const float* src = W + (size_t)(k0 + (lane >> 5)) * N + n0 + (lane & 31);
#pragma unroll
    for (int i = 0; i < 32; ++i) tv[i] = src[(size_t)(2 * i) * N];
}
__device__ __forceinline__ void transpose_store(const float (&tv)[32], int K, int N, bf16_t* WT, const float* kscale, int half, LAS float* scr, int item, int lane) {
    const int nblk = N / 32, kb = item / nblk, nb = item % nblk, k0 = 64 * kb, n0 = 32 * nb;
#pragma unroll
    for (int i = 0; i < 32; ++i) { const int kk = 2 * i + (lane >> 5); float v = tv[i]; if (kscale) v *= kscale[k0 + kk]; scr[kk * 33 + (lane & 31)] = v; }
    asm volatile("s_waitcnt lgkmcnt(0)" ::: "memory");
    const int c = lane & 7;
    const int d0 = half ? ((n0 % half) / 128) * 256 + (n0 / half) * 128 + (n0 % 128) : n0;
#pragma unroll
    for (int j = 0; j < 4; ++j) { const int n = (lane >> 3) + 8 * j; const LAS float* s = scr + (8 * c) * 33 + n;
        u32x4 o; o.x = cvt_pk_bf16(s[0 * 33], s[1 * 33]); o.y = cvt_pk_bf16(s[2 * 33], s[3 * 33]); o.z = cvt_pk_bf16(s[4 * 33], s[5 * 33]); o.w = cvt_pk_bf16(s[6 * 33], s[7 * 33]);
        *(u32x4*)(WT + (size_t)(d0 + n) * K + k0 + 8 * c) = o; }
    asm volatile("s_waitcnt lgkmcnt(0)" ::: "memory");
}
__device__ __forceinline__ void prep_mat(const Ctx& C, const float* W, int K, int N, bf16_t* WT, const float* kscale, int half) {
    LAS float* scr = (LAS float*)(C.lds + C.wave * 16384);
    const int gw = C.wg * NWAVES + C.wave, NGW = C.G * NWAVES, items = (K / 64) * (N / 32);
    float ta[32], tb[32];
    int it = gw;
    if (it < items) transpose_load(ta, W, N, it, C.lane);
    while (it < items) {
        const int nit = it + NGW;
        if (nit < items) transpose_load(tb, W, N, nit, C.lane);
        transpose_store(ta, K, N, WT, kscale, half, scr, it, C.lane);
#pragma unroll
        for (int i = 0; i < 32; ++i) ta[i] = tb[i];
        it = nit;
    }
}

__device__ __forceinline__ void x_in_phase(const Ctx& C, const float* src, bf16_t* xn, float* hss) {
    const int gw = C.wg * NWAVES + C.wave, NGW = C.G * NWAVES;
    for (int m = gw; m < M_TOK; m += NGW) {
        const f32x4* xr = (const f32x4*)(src + (size_t)m * DM) + C.lane;
        f32x4 v[8]; float ss = 0.f;
#pragma unroll
        for (int j = 0; j < 8; ++j) { v[j] = xr[64 * j]; ss += (v[j][0] * v[j][0] + v[j][1] * v[j][1]) + (v[j][2] * v[j][2] + v[j][3] * v[j][3]); }
        ss = wave_sum(ss);
        u32x2* o = (u32x2*)(xn + (size_t)m * DM) + C.lane;
#pragma unroll
        for (int j = 0; j < 8; ++j) { u32x2 w; w.x = cvt_pk_bf16(v[j][0], v[j][1]); w.y = cvt_pk_bf16(v[j][2], v[j][3]); o[64 * j] = w; }
        if (C.lane < 32) hss[(size_t)m * 64 + C.lane] = C.lane == 0 ? ss : 0.f;
    }
}
__device__ __forceinline__ void final_norm_phase(const Ctx& C, const bf16_t* xn, const float* hss, const float* gfin, float* outf) {
    const int gw = C.wg * NWAVES + C.wave, NGW = C.G * NWAVES;
    for (int m = gw; m < M_TOK; m += NGW) {
        float s = C.lane < 32 ? hss[(size_t)m * 64 + C.lane] : 0.f;
        const float rs = 1.0f / sqrtf(wave_sum(s) * (1.0f / DM) + EPS);
        const u32x4* xr = (const u32x4*)(xn + (size_t)m * DM) + C.lane;
        f32x4* o = (f32x4*)(outf + (size_t)m * DM); const f32x4* g4 = (const f32x4*)gfin;
#pragma unroll
        for (int j = 0; j < 4; ++j) { const u32x4 r = xr[64 * j]; const int c4 = 2 * (C.lane + 64 * j);
            o[c4] = pg8::bf4lo(r) * rs * g4[c4]; o[c4 + 1] = pg8::bf4hi(r) * rs * g4[c4 + 1]; }
    }
}

__device__ __forceinline__ void s5_prep(const Ctx& C, const float* a_re, const float* a_im, const float* log_dt, const float* b_re, const float* b_im, const float* c_re, const float* c_im,
                                        float* ABAR, bf16_t* BB, bf16_t* CM) {
    const int gt = C.wg * (NWAVES * 64) + C.tid, NT = C.G * NWAVES * 64;
    for (int idx = gt; idx < 128 * 64; idx += NT) {
        const int g = idx >> 6, p = idx & 63;
        const double dt = (double)expf(log_dt[g]);
        const double lr = (double)a_re[idx], li = (double)a_im[idx];
        const double xr = dt * lr; double e = 1.0, term = 1.0;
        for (int k = 1; k <= 14; ++k) { term *= xr / k; e += term; }
        const double x = dt * li; const double kq = rint(x * 0.63661977236758134308); const double r = (x - kq * 1.57079632679489655800) - kq * 6.123233995736766e-17;
        const double r2 = r * r; double sn = r, cs = 1.0, ts = r, tc = 1.0;
        for (int k = 1; k <= 10; ++k) { tc *= -r2 / ((2 * k - 1) * (2 * k)); cs += tc; ts *= -r2 / ((2 * k) * (2 * k + 1)); sn += ts; }
        const int qd = ((int)kq) & 3; double c_ = cs, s_ = sn;
        if (qd == 1) { c_ = -sn; s_ = cs; } else if (qd == 2) { c_ = -cs; s_ = -sn; } else if (qd == 3) { c_ = sn; s_ = -cs; }
        const double abr = e * c_, abi = e * s_;
        ABAR[idx * 2] = (float)abr; ABAR[idx * 2 + 1] = (float)abi;
        const double den = lr * lr + li * li;
        const double qr = ((abr - 1.0) * lr + abi * li) / den, qi = (abi * lr - (abr - 1.0) * li) / den;
        for (int c = 0; c < 16; ++c) {
            const double br = (double)b_re[(size_t)idx * 16 + c], bi = (double)b_im[(size_t)idx * 16 + c];
            const float bbr = (float)(qr * br - qi * bi), bbi = (float)(qr * bi + qi * br);
            BB[((size_t)g * 128 + p) * 16 + c] = (bf16_t)(cvt_pk_bf16(bbr, 0.f) & 0xffffu);
            BB[((size_t)g * 128 + 64 + p) * 16 + c] = (bf16_t)(cvt_pk_bf16(bbi, 0.f) & 0xffffu);
            const float cr = c_re[((size_t)g * 16 + c) * 64 + p], ci = c_im[((size_t)g * 16 + c) * 64 + p];
            *(unsigned*)(CM + ((size_t)g * 16 + c) * 128 + 2 * p) = cvt_pk_bf16(cr, -ci);
        }
    }
}

__device__ __forceinline__ void ws_prep(const Ctx& C, const float* ws, bf16_t* WSB) {
    const int gt = C.wg * (NWAVES * 64) + C.tid, NT = C.G * NWAVES * 64;
    for (int i = gt; i < 16 * 128 * 128 / 2; i += NT) { const int e = 2 * i, t = (e >> 7) & 127, s = e & 127; const f32x2 w = *(const f32x2*)(ws + e);
        *(unsigned*)(WSB + e) = cvt_pk_bf16(s <= t ? w.x : 0.f, s + 1 <= t ? w.y : 0.f); }
}

__device__ __forceinline__ unsigned off_b(unsigned row, unsigned ch) { return 256u * row + 16u * (ch ^ (((row & 3) << 2) | ((row >> 2) & 3))); }
__device__ __forceinline__ unsigned tr_read_addr_16(unsigned lane, unsigned c, unsigned ks, unsigned t) {
    const unsigned g = lane >> 4, q = (lane & 15) >> 2, p = lane & 3;
    return off_b(32 * ks + 8 * g + 4 * t + q, 2 * c + (p >> 1)) + 8 * (p & 1);
}
__device__ __forceinline__ void tr_read8(bf16x8 (&v)[4], const unsigned (&a)[8]) {
    u32x2 r0, r1, r2, r3, r4, r5, r6, r7;
    asm volatile("ds_read_b64_tr_b16 %0, %8\n\tds_read_b64_tr_b16 %1, %9\n\tds_read_b64_tr_b16 %2, %10\n\tds_read_b64_tr_b16 %3, %11\n\t"
                 "ds_read_b64_tr_b16 %4, %12\n\tds_read_b64_tr_b16 %5, %13\n\tds_read_b64_tr_b16 %6, %14\n\tds_read_b64_tr_b16 %7, %15\n\ts_waitcnt lgkmcnt(0)"
                 : "=&v"(r0), "=&v"(r1), "=&v"(r2), "=&v"(r3), "=&v"(r4), "=&v"(r5), "=&v"(r6), "=&v"(r7)
                 : "v"(a[0]), "v"(a[1]), "v"(a[2]), "v"(a[3]), "v"(a[4]), "v"(a[5]), "v"(a[6]), "v"(a[7]) : "memory");
    v[0] = __builtin_bit_cast(bf16x8, (u32x4){r0.x, r0.y, r1.x, r1.y}); v[1] = __builtin_bit_cast(bf16x8, (u32x4){r2.x, r2.y, r3.x, r3.y});
    v[2] = __builtin_bit_cast(bf16x8, (u32x4){r4.x, r4.y, r5.x, r5.y}); v[3] = __builtin_bit_cast(bf16x8, (u32x4){r6.x, r6.y, r7.x, r7.y});
}
__device__ __forceinline__ void sgu_phase(const Ctx& C, const bf16_t* Z1, const float* VSS, const float* gv, const bf16_t* WSB, const float* bs, bf16_t* Gout) {
    LAS unsigned char* Vs = C.lds;
    LAS float* rsv = (LAS float*)(C.lds + 32768);
    const int lane = C.lane, w = C.wave, fr = lane & 15, g4 = lane >> 4;
    const unsigned ldsbase = (unsigned)(uintptr_t)Vs;
    const int tb = w >> 1, dh = w & 1;
    const int ch = C.tid & 15, srow = C.tid >> 4;
    for (int task = C.wg; task < M_TOK / CHK; task += C.G) {
        const int tok0 = task * CHK;
        __syncthreads();
        if (C.tid < 128) { const f32x4* p = (const f32x4*)(VSS + (size_t)(tok0 + C.tid) * 32); float s = 0.f;
#pragma unroll
            for (int i = 0; i < 8; ++i) { const f32x4 q = p[i]; s += (q[0] + q[1]) + (q[2] + q[3]); }
            rsv[C.tid] = 1.0f / sqrtf(s * (1.0f / DM) + EPS); }
        u32x4 vraw[4];
#pragma unroll
        for (int ps = 0; ps < 4; ++ps) vraw[ps] = *(const u32x4*)(Z1 + (size_t)(tok0 + ps * 32 + srow) * 4096 + 2048 + 8 * ch);
        __syncthreads();
        for (int h = 0; h < 16; ++h) {
            {
                const f32x4 ga = *(const f32x4*)(gv + 128 * h + 8 * ch), gb = *(const f32x4*)(gv + 128 * h + 8 * ch + 4);
#pragma unroll
                for (int ps = 0; ps < 4; ++ps) { const int s = ps * 32 + srow; const u32x4 raw = vraw[ps]; const float r = rsv[s];
                    u32x4 o; o.x = cvt_pk_bf16(bflo(raw.x) * r * ga[0], bfhi(raw.x) * r * ga[1]); o.y = cvt_pk_bf16(bflo(raw.y) * r * ga[2], bfhi(raw.y) * r * ga[3]);
                    o.z = cvt_pk_bf16(bflo(raw.z) * r * gb[0], bfhi(raw.z) * r * gb[1]); o.w = cvt_pk_bf16(bflo(raw.w) * r * gb[2], bfhi(raw.w) * r * gb[3]);
                    *(LAS u32x4*)(Vs + off_b(s, ch)) = o; }
            }
            if (h + 1 < 16) {
#pragma unroll
                for (int ps = 0; ps < 4; ++ps) vraw[ps] = *(const u32x4*)(Z1 + (size_t)(tok0 + ps * 32 + srow) * 4096 + 2048 + 128 * (h + 1) + 8 * ch);
            }
            bf16x8 wf[4][2];
#pragma unroll
            for (int kk = 0; kk < 4; ++kk)
#pragma unroll
                for (int mt = 0; mt < 2; ++mt) wf[kk][mt] = *(const bf16x8*)(WSB + ((size_t)h * 128 + 32 * tb + 16 * mt + fr) * 128 + 32 * (kk <= tb ? kk : tb) + 8 * g4);
            u32x2 uu[2][4];
#pragma unroll
            for (int mt = 0; mt < 2; ++mt)
#pragma unroll
                for (int nt = 0; nt < 4; ++nt) uu[mt][nt] = *(const u32x2*)(Z1 + (size_t)(tok0 + 32 * tb + 16 * mt + fr) * 4096 + 128 * h + 64 * dh + 16 * nt + 4 * g4);
            __syncthreads();
            f32x4 acc[2][4];
#pragma unroll
            for (int a = 0; a < 2; ++a)
#pragma unroll
                for (int b = 0; b < 4; ++b) acc[a][b] = (f32x4){0.f, 0.f, 0.f, 0.f};
#pragma unroll
            for (int kk = 0; kk < 4; ++kk) {
                if (kk <= tb) {
                    unsigned ad[8]; bf16x8 vf[4];
#pragma unroll
                    for (int nt = 0; nt < 4; ++nt) { ad[2 * nt] = ldsbase + tr_read_addr_16(lane, 4 * dh + nt, kk, 0); ad[2 * nt + 1] = ldsbase + tr_read_addr_16(lane, 4 * dh + nt, kk, 1); }
                    tr_read8(vf, ad);
#pragma unroll
                    for (int nt = 0; nt < 4; ++nt)
#pragma unroll
                        for (int mt = 0; mt < 2; ++mt) acc[mt][nt] = __builtin_amdgcn_mfma_f32_16x16x32_bf16(vf[nt], wf[kk][mt], acc[mt][nt], 0, 0, 0);
                }
            }
#pragma unroll
            for (int mt = 0; mt < 2; ++mt) { const int t = 32 * tb + 16 * mt + fr; const float bias = bs[h * 128 + t];
#pragma unroll
                for (int nt = 0; nt < 4; ++nt) { const int d = 128 * h + 64 * dh + 16 * nt + 4 * g4; const u32x2 u2 = uu[mt][nt];
                    u32x2 o; o.x = cvt_pk_bf16(bflo(u2.x) * (acc[mt][nt][0] + bias), bfhi(u2.x) * (acc[mt][nt][1] + bias)); o.y = cvt_pk_bf16(bflo(u2.y) * (acc[mt][nt][2] + bias), bfhi(u2.y) * (acc[mt][nt][3] + bias));
                    *(u32x2*)(Gout + (size_t)(tok0 + t) * DM + d) = o; } }
            __syncthreads();
        }
    }
}

constexpr int S5_SUB = 16, S5_NS = SEQ / S5_SUB, S5_HP = 272;
__device__ __forceinline__ void s5_phase(const Ctx& C, const bf16_t* U, bf16_t* Gout, const float* ABAR, const bf16_t* BB, const bf16_t* CM, const float* Dsk) {
    const int lane = C.lane, fr = lane & 15, g4 = lane >> 4, pw = C.wave & 3, role = C.wave >> 2;
    for (int task = C.wg; task < NBATCH * 32; task += C.G) {
        const int b = task >> 5, g = (task & 31) * 4 + pw;
        const size_t tokb = (size_t)b * SEQ;
        LAS unsigned char* bub = C.lds + pw * 16384;
        LAS unsigned char* hb = C.lds + 65536 + pw * (2 * S5_SUB * S5_HP);
        __syncthreads();
        if (role == 1) {
            bf16x8 bfr[8], cfr[4], dfr; const bf16x8 zero8 = (bf16x8){0, 0, 0, 0, 0, 0, 0, 0};
#pragma unroll
            for (int n = 0; n < 8; ++n) bfr[n] = g4 < 2 ? *(const bf16x8*)(BB + ((size_t)g * 128 + 16 * n + fr) * 16 + 8 * g4) : zero8;
#pragma unroll
            for (int kk = 0; kk < 4; ++kk) cfr[kk] = *(const bf16x8*)(CM + ((size_t)g * 16 + fr) * 128 + 32 * kk + 8 * g4);
            { const unsigned dv = cvt_pk_bf16(Dsk[16 * g + fr], 0.f) & 0xffffu; dfr = zero8;
#pragma unroll
              for (int j = 0; j < 8; ++j) if (g4 < 2 && 8 * g4 + j == fr) dfr[j] = (short)dv; }
            const bf16_t* up = U + tokb * DM + 16 * g + 8 * g4;
            const LAS unsigned char* uring = C.lds + 100352 + pw * 4096;
            const unsigned uoff = (unsigned)(2 * fr + g4) * 16u;
            LDS_BARRIER();
            for (int i = -1; i <= S5_NS; ++i) {
                const bf16x8 uf = g4 < 2 ? *(const LAS bf16x8*)(uring + ((i + 1) & 7) * 512 + uoff) : zero8;
                const bf16x8 us = g4 < 2 ? *(const LAS bf16x8*)(uring + ((i - 1) & 7) * 512 + uoff) : zero8;
                const LAS unsigned char* src = hb + ((i - 1) & 1) * (S5_SUB * S5_HP) + fr * S5_HP + 16 * g4;
                bf16x8 hf[4];
#pragma unroll
                for (int kk = 0; kk < 4; ++kk) hf[kk] = *(const LAS bf16x8*)(src + 64 * kk);
                LAS unsigned char* dst = bub + ((i + 1) & 1) * 4096;
                f32x4 a[8];
#pragma unroll
                for (int n = 0; n < 8; ++n) a[n] = __builtin_amdgcn_mfma_f32_16x16x32_bf16(uf, bfr[n], (f32x4){0.f, 0.f, 0.f, 0.f}, 0, 0, 0);
                f32x4 y1 = __builtin_amdgcn_mfma_f32_16x16x32_bf16(dfr, us, (f32x4){0.f, 0.f, 0.f, 0.f}, 0, 0, 0);
                f32x4 y2 = __builtin_amdgcn_mfma_f32_16x16x32_bf16(cfr[2], hf[2], (f32x4){0.f, 0.f, 0.f, 0.f}, 0, 0, 0);
                y1 = __builtin_amdgcn_mfma_f32_16x16x32_bf16(cfr[0], hf[0], y1, 0, 0, 0);
                y2 = __builtin_amdgcn_mfma_f32_16x16x32_bf16(cfr[3], hf[3], y2, 0, 0, 0);
                y1 = __builtin_amdgcn_mfma_f32_16x16x32_bf16(cfr[1], hf[1], y1, 0, 0, 0);
#pragma unroll
                for (int n = 0; n < 4; ++n) { u32x4 w;
                    w.x = cvt_pk_bf16_c(a[n][0], a[n + 4][0]); w.y = cvt_pk_bf16_c(a[n][1], a[n + 4][1]); w.z = cvt_pk_bf16_c(a[n][2], a[n + 4][2]); w.w = cvt_pk_bf16_c(a[n][3], a[n + 4][3]);
                    *(LAS u32x4*)(dst + ((g4 * 64) + 16 * n + fr) * 16) = w; }
                const f32x4 y = y1 + y2;
                if (i >= 1) {
                    u32x2 o; o.x = cvt_pk_bf16_c(gelu_f(y[0]), gelu_f(y[1])); o.y = cvt_pk_bf16_c(gelu_f(y[2]), gelu_f(y[3]));
                    *(u32x2*)(Gout + (tokb + 16 * (i - 1) + fr) * DM + 16 * g + 4 * g4) = o;
                }
                LDS_BARRIER();
            }
        } else {
            const f32x2 ab = *(const f32x2*)(ABAR + ((size_t)g * 64 + lane) * 2);
            float hr = 0.f, hi = 0.f;
            LAS unsigned char* uring = C.lds + 100352 + pw * 4096;
            const bf16_t* usrc = U + (tokb + 16 * (lane >> 5) + ((lane & 31) >> 1)) * DM + 16 * g + 8 * (lane & 1);
#define S5_DMA(s0) __builtin_amdgcn_global_load_lds((const unsigned*)(usrc + (size_t)(16 * (s0)) * DM), (LAS unsigned*)(uring + ((s0) & 7) * 512), 16, 0, 0)
            S5_DMA(0); S5_DMA(2);
            asm volatile("s_waitcnt vmcnt(0)" ::: "memory");
            LDS_BARRIER();
            for (int i = -1; i <= S5_NS; ++i) {
                if ((i & 1) && i + 5 < S5_NS) S5_DMA(i + 5);
                if (i >= 0 && i < S5_NS) {
                    const LAS unsigned char* src = bub + (i & 1) * 4096 + lane * 16;
                    LAS unsigned char* dst = hb + (i & 1) * (S5_SUB * S5_HP) + lane * 4;
                    u32x4 bq[S5_SUB / 4];
#pragma unroll
                    for (int q = 0; q < S5_SUB / 4; ++q) bq[q] = *(const LAS u32x4*)(src + q * 1024);
#pragma unroll
                    for (int t = 0; t < S5_SUB; ++t) {
                        const unsigned bw = bq[t >> 2][t & 3];
                        const float nr = ab.x * hr - ab.y * hi + bflo(bw), ni = ab.x * hi + ab.y * hr + bfhi(bw);
                        hr = nr; hi = ni;
                        *(LAS unsigned*)(dst + t * S5_HP) = cvt_pk_bf16(hr, hi);
                    }
                }
                if (i + 7 < S5_NS) asm volatile("s_waitcnt vmcnt(1)" ::: "memory");
                else asm volatile("s_waitcnt vmcnt(0)" ::: "memory");
                LDS_BARRIER();
            }
#undef S5_DMA
        }
    }
}

__device__ __forceinline__ void fixup_phase(const Ctx& C, const float* ZH, const float* cw, const float* cb, bf16_t* HID) {
    const int gt = C.wg * (NWAVES * 64) + C.tid, NT = C.G * NWAVES * 64;
    const f32x4 zero4 = (f32x4){0.f, 0.f, 0.f, 0.f};
    for (int idx = gt; idx < 128 * 2 * (FF / 4); idx += NT) {
        const int c = 4 * (idx % (FF / 4)), rr = (idx / (FF / 4)) & 1, pm = idx / (2 * (FF / 4));
        const bool first = (pm & 15) == 0;
        f32x4 o[2];
#pragma unroll
        for (int hf = 0; hf < 2; ++hf) { const int cc = c + hf * FF;
            const f32x4 zt = *(const f32x4*)(ZH + (size_t)(pm * 4 + rr) * FF2 + cc);
            const f32x4 p3 = first ? zero4 : *(const f32x4*)(ZH + (size_t)((pm - 1) * 4 + 3) * FF2 + cc);
            f32x4 z1, z2;
            if (rr == 1) { z1 = *(const f32x4*)(ZH + (size_t)(pm * 4 + 0) * FF2 + cc); z2 = p3; }
            else { z1 = p3; z2 = first ? zero4 : *(const f32x4*)(ZH + (size_t)((pm - 1) * 4 + 2) * FF2 + cc); }
            o[hf] = *(const f32x4*)(cb + cc) + *(const f32x4*)(cw + 2 * FF2 + cc) * zt + *(const f32x4*)(cw + FF2 + cc) * z1 + *(const f32x4*)(cw + cc) * z2; }
        u32x2 w; w.x = cvt_pk_bf16(o[0][0] * sigmoid_f(o[0][0]) * o[1][0], o[0][1] * sigmoid_f(o[0][1]) * o[1][1]); w.y = cvt_pk_bf16(o[0][2] * sigmoid_f(o[0][2]) * o[1][2], o[0][3] * sigmoid_f(o[0][3]) * o[1][3]);
        *(u32x2*)(HID + (size_t)(pm * 256 + rr) * FF + c) = w;
    }
}

struct Args { const float* in[23]; float* out; unsigned char* ws; int ph_lo, ph_hi; };
#ifndef DUPST
#define DUPST (-1)
#endif
constexpr int PPL = 6 + (DUPST >= 0 ? 1 : 0);
constexpr int N_PHASES = 2 + PPL * DEPTH;
#ifndef PHMASK
#define PHMASK 0xFFFF
#endif
#define EN(k) (((PHMASK) >> (k)) & 1)
#ifndef DUP
#define DUP 0
#endif
#define DUPN(k) ((((DUP) >> (k)) & 1) ? 2 : 1)

template <class Epi> __device__ __forceinline__ void run_gemm(const Ctx& C, const bf16_t* A, const bf16_t* Bt, int N, int K, Epi& E, const float* hss, int np) {
    pg8::Gemm g{A, Bt, M_TOK, N, K}; pg8::StaticOrder S; S.init(M_TOK, N, C.G, C.wg, hss ? 8 : 4);
    pg8::Unit u0, u1, t; S.next(0, u0); u1 = u0; for (int i = 1; S.next(i, t); ++i) u1 = t;
    {
        LAS float* RS = (LAS float*)(C.lds + RS_OFF);
        float rs = 1.0f;
        if (hss) { const int row = (C.tid < 256 ? u0.pm : u1.pm) * 256 + (C.tid & 255); const f32x4* p4 = (const f32x4*)(hss + (size_t)row * 64); float s = 0.f;
            for (int i = 0; i < np / 4; ++i) { const f32x4 q = p4[i]; s += (q[0] + q[1]) + (q[2] + q[3]); }
            rs = 1.0f / sqrtf(s * (1.0f / DM) + EPS); }
        RS[C.tid] = rs;
        __syncthreads();
    }
    E.pm0 = u0.pm;
    pg8::gemm_phase<Epi, pg8::StaticOrder, true, true>(C.lds, g, S, E, C.tid);
}

__device__ __forceinline__ unsigned long long ld_ptr(const LAS unsigned long long* p) {
    const unsigned long long v = *p; const unsigned lo = __builtin_amdgcn_readfirstlane((unsigned)v), hi = __builtin_amdgcn_readfirstlane((unsigned)(v >> 32));
    return ((unsigned long long)hi << 32) | lo;
}
__global__ void __launch_bounds__(NWAVES * 64, 2) mk_fwd(Args a) {
    extern __shared__ __attribute__((aligned(16))) unsigned char lds_raw[];
    unsigned char* ws = a.ws;
    float* H = a.out;
    bf16_t* XN = (bf16_t*)(ws + WS_XN); bf16_t* Z1 = (bf16_t*)(ws + WS_Z1); bf16_t* GB = (bf16_t*)(ws + WS_G); bf16_t* HID = (bf16_t*)(ws + WS_HID);
    float* VSS = (float*)(ws + WS_VSS); float* ZH = (float*)(ws + WS_ZH); float* HSS = (float*)(ws + WS_HSS);
    unsigned char* WB = ws + WS_W;

    LAS unsigned long long* PT = (LAS unsigned long long*)((LAS unsigned char*)lds_raw + MISC_OFF + 64);
    if (threadIdx.x == 0) {
#pragma unroll
        for (int i = 0; i < 23; ++i) PT[i] = (unsigned long long)a.in[i];
    }
#define IN(i) ((const float*)ld_ptr(PT + (i)))
    volatile LAS unsigned* MISC = (volatile LAS unsigned*)((LAS unsigned char*)lds_raw + MISC_OFF);
    if (threadIdx.x < 2) MISC[threadIdx.x] = 0u;
    __syncthreads();
    XcdBarrier bar; bar.bar = (unsigned*)ws; bar.x = 0; bar.st = MISC;
    if (a.ph_hi - a.ph_lo > 1) bar = xcd_barrier_post((unsigned*)ws, MISC);
    for (int ph = a.ph_lo; ph < a.ph_hi; ++ph) {
        int tid_l = threadIdx.x; asm volatile("" : "+v"(tid_l));
        Ctx C; C.lds = (LAS unsigned char*)lds_raw; C.tid = tid_l; C.lane = C.tid & 63; C.wave = __builtin_amdgcn_readfirstlane(C.tid >> 6); C.wg = blockIdx.x; C.G = gridDim.x;
        if (ph == 0) { if constexpr (EN(0)) { for (int dup = 0; dup < DUPN(0); ++dup) {
            for (int j = 0; j < 2; ++j) {
                prep_mat(C, IN(3) + (size_t)j * DM * 4096, DM, 4096, (bf16_t*)(WB + W_AIN + j * S_AIN), IN(1) + (2 * j) * DM, 0);
                prep_mat(C, IN(7) + (size_t)j * DM * DM, DM, DM, (bf16_t*)(WB + W_AOUT + j * S_AOUT), nullptr, 0);
                prep_mat(C, IN(8) + (size_t)j * DM * DM, DM, DM, (bf16_t*)(WB + W_BIN + j * S_BIN), IN(1) + (2 * j + 1) * DM, 0);
                prep_mat(C, IN(17) + (size_t)j * DM * 4096, DM, 4096, (bf16_t*)(WB + W_GLU + j * S_GLU), nullptr, 2048);
                s5_prep(C, IN(9) + j * 8192, IN(10) + j * 8192, IN(11) + j * 128, IN(12) + (size_t)j * 131072, IN(13) + (size_t)j * 131072, IN(14) + (size_t)j * 131072, IN(15) + (size_t)j * 131072,
                        (float*)(ws + WS_ABAR) + j * 16384, (bf16_t*)(ws + WS_BB) + (size_t)j * 262144, (bf16_t*)(ws + WS_CM) + (size_t)j * 262144);
                ws_prep(C, IN(5) + (size_t)j * 262144, (bf16_t*)(ws + WS_WSB) + (size_t)j * 262144);
            }
            for (int i = 0; i < DEPTH; ++i) {
                prep_mat(C, IN(18) + (size_t)i * DM * FF2, DM, FF2, (bf16_t*)(WB + W_UP + i * S_UP), IN(2) + i * DM, FF);
                prep_mat(C, IN(21) + (size_t)i * FF * DM, FF, DM, (bf16_t*)(WB + W_DOWN + i * S_DOWN), nullptr, 0);
            }
            x_in_phase(C, IN(0), XN, HSS);
        } } } else if (ph == N_PHASES - 1) {
            if constexpr (EN(11)) final_norm_phase(C, XN, HSS, IN(22), H);
        } else {
            const int L = (ph - 1) / PPL, pos = (ph - 1) % PPL, st = (DUPST >= 0 && pos > DUPST) ? pos - 1 : pos, j = L >> 1; const bool isA = (L & 1) == 0;
            const float* hss_in = HSS;
            if (st == 0) {
                if (isA) { if constexpr (EN(1)) { pg8::EpiGeluSS E{Z1, VSS, 0}; run_gemm(C, XN, (const bf16_t*)(WB + W_AIN + j * S_AIN), 4096, DM, E, hss_in, 32); } }
                else { if constexpr (EN(2)) { pg8::EpiPlainBf16 E{Z1, DM, 0}; run_gemm(C, XN, (const bf16_t*)(WB + W_BIN + j * S_BIN), DM, DM, E, hss_in, 32); } }
            } else if (st == 1) {
                if (isA) { if constexpr (EN(3)) sgu_phase(C, Z1, VSS, IN(4) + j * DM, (const bf16_t*)(ws + WS_WSB) + (size_t)j * 262144, IN(6) + j * 2048, GB); }
                else if constexpr (EN(4)) s5_phase(C, Z1, GB, (const float*)(ws + WS_ABAR) + j * 16384, (const bf16_t*)(ws + WS_BB) + (size_t)j * 262144, (const bf16_t*)(ws + WS_CM) + (size_t)j * 262144, IN(16) + j * DM);
            } else if (st == 2) {
                if (isA) { if constexpr (EN(5)) { pg8::EpiRes E{XN, HSS, 0}; run_gemm(C, GB, (const bf16_t*)(WB + W_AOUT + j * S_AOUT), DM, DM, E, nullptr, 0); } }
                else { if constexpr (EN(6)) { pg8::EpiGlu E{XN, HSS, 0}; run_gemm(C, GB, (const bf16_t*)(WB + W_GLU + j * S_GLU), 4096, DM, E, nullptr, 0); } }
            } else if (st == 3) {
                if constexpr (EN(8)) { pg8::EpiUp E{HID, ZH, IN(19) + (size_t)L * 3 * FF2, IN(20) + (size_t)L * FF2, 0}; run_gemm(C, XN, (const bf16_t*)(WB + W_UP + L * S_UP), FF2, DM, E, HSS, isA ? 32 : 64); }
            } else if (st == 4) {
                if constexpr (EN(9)) fixup_phase(C, ZH, IN(19) + (size_t)L * 3 * FF2, IN(20) + (size_t)L * FF2, HID);
            } else {
                if constexpr (EN(10)) { pg8::EpiRes E{XN, HSS, 0}; run_gemm(C, HID, (const bf16_t*)(WB + W_DOWN + L * S_DOWN), DM, FF, E, nullptr, 0); }
            }
        }
        if (ph + 1 < a.ph_hi) { for (int dup = 0; dup < DUPN(7); ++dup) {
            if (a.ph_hi > 4096) { __syncthreads(); cg::this_grid().sync(); }
            else xcd_barrier(bar); } }
    }
}

#undef IN
extern "C" void kernel_launch(void* const* d_in, const int* in_sizes, int n_in, void* d_out, int out_size, void* d_ws, size_t ws_size, hipStream_t stream) {
    static int grid = 0;
    if (grid == 0) {
        if (n_in != 23 || out_size != M_TOK * DM || ws_size < WS_END) { fprintf(stderr, "kernel_launch: unexpected shapes (n_in %d out %d ws %zu)\n", n_in, out_size, ws_size); grid = -1; return; }
        int dev = 0, cus = 0, per_cu = 0;
        hipGetDevice(&dev); hipDeviceGetAttribute(&cus, hipDeviceAttributeMultiprocessorCount, dev);
        if (hipFuncSetAttribute((const void*)mk_fwd, hipFuncAttributeMaxDynamicSharedMemorySize, LDS_BYTES) != hipSuccess) { fprintf(stderr, "kernel_launch: hipFuncSetAttribute failed\n"); grid = -1; return; }
        if (hipOccupancyMaxActiveBlocksPerMultiprocessor(&per_cu, (const void*)mk_fwd, NWAVES * 64, LDS_BYTES) != hipSuccess || per_cu < 1) { fprintf(stderr, "kernel_launch: occupancy query says %d\n", per_cu); per_cu = 1; }
        (void)hipGetLastError();
        grid = cus;
    }
    if (grid < 0) return;
    if (hipMemsetAsync(d_ws, 0, 65536, stream) != hipSuccess) { fprintf(stderr, "kernel_launch: memset failed\n"); return; }
    Args a{};
    for (int i = 0; i < 23; ++i) a.in[i] = (const float*)d_in[i];
    a.out = (float*)d_out; a.ws = (unsigned char*)d_ws;
#if MK_MULTI
    for (int p = 0; p < N_PHASES; ++p) { a.ph_lo = p; a.ph_hi = p + 1; hipLaunchKernelGGL(mk_fwd, dim3(grid), dim3(NWAVES * 64), LDS_BYTES, stream, a); }
#else
    a.ph_lo = 0; a.ph_hi = N_PHASES;
    void* args[] = {&a};
    hipError_t e = hipLaunchCooperativeKernel((const void*)mk_fwd, dim3(grid), dim3(NWAVES * 64), args, LDS_BYTES, stream);
    if (e != hipSuccess) fprintf(stderr, "kernel_launch: cooperative launch failed: %s (grid %d)\n", hipGetErrorString(e), grid);
#endif
}
```
